# Optimizing an MI355X kernel written in HIP

```python
import jax, jax.numpy as jnp
from jax import lax
import numpy as np

D_MODEL = 1024
BATCH = 4
SEQ = 8192
DEPTH = 4

CHUNK = 64
N_EVEN = (DEPTH + 1) // 2
N_ODD = DEPTH // 2
EPS = 1e-6

LRU_WIDTH = D_MODEL // 2
LRU_HEADS = 8
LRU_HEAD_DIM = LRU_WIDTH // LRU_HEADS
LRU_CONV = 4
LRU_C = 8.0
SCONV_WIDTH = D_MODEL // 2
SCONV_K = 3
EVEN_IN = 2 * LRU_WIDTH + 3 * SCONV_WIDTH
SPLIT_EVEN = (LRU_WIDTH, 2 * LRU_WIDTH, 2 * LRU_WIDTH + SCONV_WIDTH, 2 * LRU_WIDTH + 2 * SCONV_WIDTH)
EVEN_MIX = LRU_WIDTH + SCONV_WIDTH

POOL_WIDTH = D_MODEL // 2
POOL_WINDOWS = (2, 4, 8, 16)
POOL_GROUPS = len(POOL_WINDOWS)
POOL_GROUP = POOL_WIDTH // POOL_GROUPS
HGRN_WIDTH = D_MODEL // 2
HGRN_HEADS = 4
HGRN_DK = HGRN_WIDTH // HGRN_HEADS
HGRN_DV = HGRN_WIDTH // HGRN_HEADS
ODD_IN = POOL_WIDTH + 4 * HGRN_WIDTH
SPLIT_ODD = (POOL_WIDTH, POOL_WIDTH + HGRN_WIDTH, POOL_WIDTH + 2 * HGRN_WIDTH, POOL_WIDTH + 3 * HGRN_WIDTH)
ODD_MIX = POOL_WIDTH + HGRN_WIDTH

FFN_DIM = 256 * ((8 * D_MODEL // 3 + 255) // 256)
FFN_K = 3

kernel_name = "hybrid_rglru_shortconv_pool_hgrn2_convffn"


def rmsnorm(x, g):
    xf = x.astype(jnp.float32)
    y = xf * lax.rsqrt(jnp.mean(xf * xf, axis=-1, keepdims=True) + EPS)
    return (y * g.astype(jnp.float32)).astype(x.dtype)


def causal_dwconv(u, w):
    K = w.shape[0]
    S = u.shape[1]
    up = jnp.pad(u, ((0, 0), (K - 1, 0), (0, 0)))
    y = up[:, K - 1:K - 1 + S] * w[K - 1]
    for j in range(K - 1):
        y = y + up[:, j:j + S] * w[j]
    return y


def rg_lru(xc, w_a, b_a, w_i, b_i, lam):
    f32 = jnp.float32
    Bsz, S, _ = xc.shape
    xf = xc.astype(f32)
    xh = xf.reshape(Bsz, S, LRU_HEADS, LRU_HEAD_DIM)
    r = jax.nn.sigmoid(jnp.einsum('bshi,hij->bshj', xh, w_a.astype(f32)).reshape(Bsz, S, LRU_WIDTH) + b_a.astype(f32))
    ig = jax.nn.sigmoid(jnp.einsum('bshi,hij->bshj', xh, w_i.astype(f32)).reshape(Bsz, S, LRU_WIDTH) + b_i.astype(f32))
    log_a = -LRU_C * r * jax.nn.softplus(-lam.astype(f32))
    mult = jnp.sqrt(-jnp.expm1(2.0 * log_a))
    mult = jnp.where(jnp.arange(S)[None, :, None] == 0, 1.0, mult)
    hb = mult * ig * xf

    def combine(left, right):
        a_l, h_l = left
        a_r, h_r = right
        return a_l * a_r, a_r * h_l + h_r

    _, h = lax.associative_scan(combine, (jnp.exp(log_a), hb), axis=1)
    return h


def pool_mixer(u, w_grp, scale):
    f32 = jnp.float32
    Bsz, S, _ = u.shape
    uf = u.astype(f32)
    cs = jnp.cumsum(uf, axis=1)
    t1 = jnp.arange(1, S + 1, dtype=f32)[None, :, None]
    outs = []
    for gi, win in enumerate(POOL_WINDOWS):
        sl = slice(gi * POOL_GROUP, (gi + 1) * POOL_GROUP)
        c = cs[..., sl]
        lag = jnp.pad(c, ((0, 0), (win, 0), (0, 0)))[:, :S]
        outs.append((c - lag) / jnp.minimum(t1, float(win)) - uf[..., sl])
    p = jnp.stack(outs, axis=2)
    y = jnp.einsum('bsgi,gio->bsgo', p, w_grp.astype(f32)).reshape(Bsz, S, POOL_WIDTH)
    return (y * scale.astype(f32)).astype(u.dtype)


def hgrn2(q, fz, v, g, lb, norm_g):
    f32 = jnp.float32
    Bsz, S, _ = q.shape
    nC = S // CHUNK
    fz = fz.astype(f32)
    lb = lb.astype(f32)
    log_f = jnp.logaddexp(jnp.log(lb), jnp.log1p(-lb) + jax.nn.log_sigmoid(fz))
    k = (1.0 - lb) * jax.nn.sigmoid(-fz)

    def chunked(a, d):
        return a.astype(f32).reshape(Bsz, nC, CHUNK, HGRN_HEADS, d)

    qc = chunked(q, HGRN_DK)
    kc = chunked(k, HGRN_DK)
    lfc = chunked(log_f, HGRN_DK)
    vc = chunked(v, HGRN_DV)

    def intra_step(s, inp):
        lf_t, k_t, v_t, q_t = inp
        s = jnp.exp(lf_t)[..., None] * s + k_t[..., None] * v_t[..., None, :]
        return s, jnp.einsum('bchk,bchkv->bchv', q_t, s)

    tm = lambda a: jnp.moveaxis(a, 2, 0)
    s0 = jnp.zeros((Bsz, nC, HGRN_HEADS, HGRN_DK, HGRN_DV), f32)
    ds, o_intra = lax.scan(intra_step, s0, (tm(lfc), tm(kc), tm(vc), tm(qc)))
    o_intra = jnp.moveaxis(o_intra, 0, 2)

    G = jnp.cumsum(lfc, axis=2)

    def inter_step(s, inp):
        dec, ds_c = inp
        return jnp.exp(dec)[..., None] * s + ds_c, s

    _, s_prev = lax.scan(inter_step, jnp.zeros((Bsz, HGRN_HEADS, HGRN_DK, HGRN_DV), f32),
                         (jnp.moveaxis(G[:, :, -1], 1, 0), jnp.moveaxis(ds, 1, 0)))
    o_inter = jnp.einsum('bclhk,cbhkv->bclhv', qc * jnp.exp(G), s_prev)
    o = (o_intra + o_inter).reshape(Bsz, S, HGRN_HEADS, HGRN_DV)
    o = o * lax.rsqrt(jnp.mean(o * o, axis=-1, keepdims=True) + EPS) * norm_g.astype(f32).reshape(HGRN_HEADS, HGRN_DV)
    o = o.reshape(Bsz, S, HGRN_WIDTH) * jax.nn.silu(g.astype(f32))
    return o.astype(q.dtype)


def setup_inputs(seed: int = 0) -> dict:
    key = jax.random.key(seed)
    ks = iter(jax.random.split(key, 32))
    f32 = jnp.float32

    def nrm(shape, s):
        return jax.random.normal(next(ks), shape, f32) * s

    x = nrm((BATCH, SEQ, D_MODEL), 1.0)
    g_mix = 1.0 + nrm((DEPTH, D_MODEL), 0.02)
    g_ffn = 1.0 + nrm((DEPTH, D_MODEL), 0.02)
    g_final = 1.0 + nrm((D_MODEL,), 0.02)
    w_in_even = nrm((N_EVEN, D_MODEL, EVEN_IN), D_MODEL ** -0.5)
    w_out_even = nrm((N_EVEN, EVEN_MIX, D_MODEL), EVEN_MIX ** -0.5)
    lru_conv_w = nrm((N_EVEN, LRU_CONV, LRU_WIDTH), LRU_CONV ** -0.5)
    lru_conv_b = nrm((N_EVEN, LRU_WIDTH), 0.02)
    lru_wa = nrm((N_EVEN, LRU_HEADS, LRU_HEAD_DIM, LRU_HEAD_DIM), LRU_HEAD_DIM ** -0.5)
    lru_ba = nrm((N_EVEN, LRU_WIDTH), 0.02)
    lru_wi = nrm((N_EVEN, LRU_HEADS, LRU_HEAD_DIM, LRU_HEAD_DIM), LRU_HEAD_DIM ** -0.5)
    lru_bi = nrm((N_EVEN, LRU_WIDTH), 0.02)
    a_c = jax.random.uniform(next(ks), (N_EVEN, LRU_WIDTH), f32, minval=0.9, maxval=0.999)
    s_a = a_c ** (1.0 / LRU_C)
    lru_lambda = jnp.log(s_a) - jnp.log1p(-s_a)
    sconv_w = nrm((N_EVEN, SCONV_K, SCONV_WIDTH), SCONV_K ** -0.5)
    w_in_odd = nrm((N_ODD, D_MODEL, ODD_IN), D_MODEL ** -0.5)
    w_out_odd = nrm((N_ODD, ODD_MIX, D_MODEL), ODD_MIX ** -0.5)
    pool_w = nrm((N_ODD, POOL_GROUPS, POOL_GROUP, POOL_GROUP), POOL_GROUP ** -0.5)
    pool_scale = 1.0 + nrm((N_ODD, POOL_WIDTH), 0.02)
    hgrn_lb_logits = nrm((N_ODD, HGRN_WIDTH), 0.5)
    hgrn_norm_g = 1.0 + nrm((N_ODD, HGRN_WIDTH), 0.02)
    ffn_w_up = nrm((DEPTH, D_MODEL, FFN_DIM), D_MODEL ** -0.5)
    ffn_w_gate = nrm((DEPTH, D_MODEL, FFN_DIM), D_MODEL ** -0.5)
    ffn_conv_w = nrm((DEPTH, FFN_K, FFN_DIM), FFN_K ** -0.5)
    ffn_conv_b = nrm((DEPTH, FFN_DIM), 0.02)
    ffn_w_down = nrm((DEPTH, FFN_DIM, D_MODEL), FFN_DIM ** -0.5)
    return {"x": x, "g_mix": g_mix, "g_ffn": g_ffn, "g_final": g_final,
            "w_in_even": w_in_even, "w_out_even": w_out_even, "lru_conv_w": lru_conv_w, "lru_conv_b": lru_conv_b,
            "lru_wa": lru_wa, "lru_ba": lru_ba, "lru_wi": lru_wi, "lru_bi": lru_bi, "lru_lambda": lru_lambda,
            "sconv_w": sconv_w, "w_in_odd": w_in_odd, "w_out_odd": w_out_odd, "pool_w": pool_w,
            "pool_scale": pool_scale, "hgrn_lb_logits": hgrn_lb_logits, "hgrn_norm_g": hgrn_norm_g,
            "ffn_w_up": ffn_w_up, "ffn_w_gate": ffn_w_gate, "ffn_conv_w": ffn_conv_w, "ffn_conv_b": ffn_conv_b,
            "ffn_w_down": ffn_w_down}


def reference(x, g_mix, g_ffn, g_final, w_in_even, w_out_even, lru_conv_w, lru_conv_b, lru_wa, lru_ba,
              lru_wi, lru_bi, lru_lambda, sconv_w, w_in_odd, w_out_odd, pool_w, pool_scale,
              hgrn_lb_logits, hgrn_norm_g, ffn_w_up, ffn_w_gate, ffn_conv_w, ffn_conv_b, ffn_w_down):
    f32 = jnp.float32
    lb_all = jnp.cumsum(jax.nn.softmax(hgrn_lb_logits.astype(f32), axis=0), axis=0)
    lb_all = lb_all - lb_all[0]
    for l in range(DEPTH):
        h = rmsnorm(x, g_mix[l])
        if l % 2 == 0:
            e = l // 2
            z = h @ w_in_even[e]
            xa, ga, hb, bg, cg = jnp.split(z, SPLIT_EVEN, axis=-1)
            xa = causal_dwconv(xa, lru_conv_w[e]) + lru_conv_b[e]
            ya = (rg_lru(xa, lru_wa[e], lru_ba[e], lru_wi[e], lru_bi[e], lru_lambda[e])
                  * jax.nn.gelu(ga.astype(f32))).astype(x.dtype)
            yb = bg * causal_dwconv(cg * hb, sconv_w[e])
            x = x + jnp.concatenate([ya, yb], axis=-1) @ w_out_even[e]
        else:
            o = l // 2
            z = h @ w_in_odd[o]
            uc, q, fz, iv, gd = jnp.split(z, SPLIT_ODD, axis=-1)
            yc = pool_mixer(uc, pool_w[o], pool_scale[o])
            yd = hgrn2(q, fz, iv, gd, lb_all[o], hgrn_norm_g[o])
            x = x + jnp.concatenate([yc, yd], axis=-1) @ w_out_odd[o]
        h = rmsnorm(x, g_ffn[l])
        u = causal_dwconv(h @ ffn_w_up[l], ffn_conv_w[l]) + ffn_conv_b[l]
        x = x + (jax.nn.gelu(u) * (h @ ffn_w_gate[l])) @ ffn_w_down[l]
    return rmsnorm(x, g_final)
```

```cpp
#include <hip/hip_runtime.h>
#include <hip/hip_cooperative_groups.h>
#include <cstdio>
#include <cstdint>
namespace cg = cooperative_groups;
__device__ __forceinline__ int tid_now() { int t = threadIdx.x; asm volatile("" : "+v"(t)); return t; }
#ifndef PG8_WGM
#define PG8_WGM 8
#endif
namespace pg8 {
#define PG8_LAS __attribute__((address_space(3)))
typedef unsigned short bf16_t;
typedef short bf16x8 __attribute__((ext_vector_type(8)));
typedef float f32x4 __attribute__((ext_vector_type(4)));
typedef unsigned u32x4 __attribute__((ext_vector_type(4)));
typedef unsigned u32x2 __attribute__((ext_vector_type(2)));
constexpr int BM = 256, BK = 64, HALF = 128, HTB = HALF * BK * 2  , STAGE_BYTES = 8 * HTB, NXCD = 8, WGM = PG8_WGM;

__host__ __device__ __forceinline__ int lds_byte(int r, int c) { const int st = (r >> 4) * 2 + (c >> 5), rr = r & 15, cc = c & 31, ob = rr * 64 + cc * 2; return st * 1024 + (ob ^ (((ob >> 9) & 1) << 5)); }
__host__ __device__ __forceinline__ void stage_rc(int b, int& R, int& C) { const int st = b / 1024, sb = b % 1024, swz = sb ^ (((sb >> 9) & 1) << 5); R = (st >> 1) * 16 + swz / 64; C = (st & 1) * 32 + (swz % 64) / 2; }
__host__ __device__ __forceinline__ int perm32(int rho) { const int n = rho >> 4, i = rho & 15; return 8 * (i >> 2) + 4 * n + (i & 3); }

struct Unit { int pm, pn; };
struct Gemm { const bf16_t* A; const bf16_t* Bt; int M, N, K; };

struct StaticOrder {
    int nM, nN, nwg, G, c;
    __host__ __device__ void init(int M, int N, int G_, int c_) { nM = M / BM; nN = N / BM; nwg = nM * nN; G = G_; c = c_; }
    __host__ __device__ bool next(int i, Unit& u) const {
        const long L = (long)i * G + c; if (L >= nwg) return false;
        int wgid = (int)L; { const int q = nwg / NXCD, r = nwg % NXCD, xcd = wgid % NXCD, off = wgid / NXCD; wgid = (xcd < r ? xcd * (q + 1) : r * (q + 1) + (xcd - r) * q) + off; }
        const int nig = WGM * nN, gid = wgid / nig, fm = gid * WGM, gsz = (nM - fm) < WGM ? (nM - fm) : WGM;
        u.pm = fm + ((wgid % nig) % gsz); u.pn = (wgid % nig) / gsz; return true;
    }
    __device__ __forceinline__ void a_ready(const Unit&) const {}
    __device__ __forceinline__ void done(const Unit&) const {}
};

__device__ __forceinline__ unsigned cvt_pk_bf16(float lo, float hi) { unsigned r; asm volatile("v_cvt_pk_bf16_f32 %0, %1, %2" : "=v"(r) : "v"(lo), "v"(hi)); return r; }

__device__ __forceinline__ float row_rstd(const float* ssq4, int r) {
    const f32x4 a = *(const f32x4*)(ssq4 + (size_t)r * 4);
    return __builtin_amdgcn_rsqf(((a[0] + a[1]) + (a[2] + a[3])) * (1.0f / 1024.0f) + 1e-6f); }
struct EpiScale {
    static constexpr bool PERM = true, AFTER_DRAIN = false;
    bf16_t* O; int ldc; const float* ssq; int skip;
    __device__ __forceinline__ void operator()(const f32x4 (&acc)[2][2][4][2], const Unit& u, int wr_, int wc_, int fr_, int fq_) const {
        const int t_ = tid_now(), fr = t_ & 15, fq = (t_ >> 4) & 3, wc = (t_ >> 6) & 3, wr = t_ >> 8;
        if (skip) return;
        const int row0 = u.pm * BM + wr * 64 + fr, col0 = u.pn * BM + wc * 32 + 8 * fq;
#pragma unroll
        for (int ai = 0; ai < 2; ++ai)
#pragma unroll
            for (int m = 0; m < 4; ++m) { const int r = row0 + ai * HALF + m * 16; const float rs = row_rstd(ssq, r);
#pragma unroll
                for (int bj = 0; bj < 2; ++bj) { const f32x4 v0 = acc[ai][bj][m][0] * rs, v1 = acc[ai][bj][m][1] * rs;
                    u32x4 w; w.x = cvt_pk_bf16(v0[0], v0[1]); w.y = cvt_pk_bf16(v0[2], v0[3]); w.z = cvt_pk_bf16(v1[0], v1[1]); w.w = cvt_pk_bf16(v1[2], v1[3]);
                    *(u32x4*)(O + ((size_t)(u.pn * 2 + bj) * 32768 + r) * 128 + wc * 32 + 8 * fq) = w; } }
    }
};
struct EpiUG {
    static constexpr bool PERM = true, AFTER_DRAIN = false;
    bf16_t* U; bf16_t* G; const float* ssq;
    __device__ __forceinline__ void operator()(const f32x4 (&acc)[2][2][4][2], const Unit& u, int wr_, int wc_, int fr_, int fq_) const {
        const int t_ = tid_now(), fr = t_ & 15, fq = (t_ >> 4) & 3, wc = (t_ >> 6) & 3, wr = t_ >> 8;
        const int row0 = u.pm * BM + wr * 64 + fr, col0 = u.pn * HALF + wc * 32 + 8 * fq;
#pragma unroll
        for (int ai = 0; ai < 2; ++ai)
#pragma unroll
            for (int m = 0; m < 4; ++m) { const int r = row0 + ai * HALF + m * 16; const float rs = row_rstd(ssq, r);
#pragma unroll
                for (int bj = 0; bj < 2; ++bj) { const f32x4 v0 = acc[ai][bj][m][0] * rs, v1 = acc[ai][bj][m][1] * rs;
                    u32x4 w; w.x = cvt_pk_bf16(v0[0], v0[1]); w.y = cvt_pk_bf16(v0[2], v0[3]); w.z = cvt_pk_bf16(v1[0], v1[1]); w.w = cvt_pk_bf16(v1[2], v1[3]);
                    *(u32x4*)((bj ? G : U) + (size_t)r * 2816 + col0) = w; } }
    }
};
struct EpiRes {
    static constexpr bool PERM = true, AFTER_DRAIN = false;
    bf16_t* X; float* ssq_next; PG8_LAS float* PS;
    __device__ __forceinline__ void operator()(const f32x4 (&acc)[2][2][4][2], const Unit& u, int wr_, int wc_, int fr_, int fq_) const {
        const int t_ = tid_now(), fr = t_ & 15, fq = (t_ >> 4) & 3, wc = (t_ >> 6) & 3, wr = t_ >> 8;
        const int row0 = u.pm * BM + wr * 64 + fr, col0 = u.pn * BM + wc * 32 + 8 * fq;
#pragma unroll
        for (int ai = 0; ai < 2; ++ai)
#pragma unroll
            for (int m = 0; m < 4; ++m) { const int r = row0 + ai * HALF + m * 16; bf16_t* xp = X + (size_t)r * 1024 + col0; float s = 0.f;
#pragma unroll
                for (int bj = 0; bj < 2; ++bj) {
                    const u32x4 xw = *(const u32x4*)(xp + bj * HALF); const f32x4 a0 = acc[ai][bj][m][0], a1 = acc[ai][bj][m][1];
                    u32x4 w; w.x = cvt_pk_bf16(__uint_as_float(xw.x << 16) + a0[0], __uint_as_float(xw.x & 0xffff0000u) + a0[1]); w.y = cvt_pk_bf16(__uint_as_float(xw.y << 16) + a0[2], __uint_as_float(xw.y & 0xffff0000u) + a0[3]);
                    w.z = cvt_pk_bf16(__uint_as_float(xw.z << 16) + a1[0], __uint_as_float(xw.z & 0xffff0000u) + a1[1]); w.w = cvt_pk_bf16(__uint_as_float(xw.w << 16) + a1[2], __uint_as_float(xw.w & 0xffff0000u) + a1[3]);
                    *(u32x4*)(xp + bj * HALF) = w;
                    const float y0 = __uint_as_float(w.x << 16), y1 = __uint_as_float(w.x & 0xffff0000u), y2 = __uint_as_float(w.y << 16), y3 = __uint_as_float(w.y & 0xffff0000u);
                    const float y4 = __uint_as_float(w.z << 16), y5 = __uint_as_float(w.z & 0xffff0000u), y6 = __uint_as_float(w.w << 16), y7 = __uint_as_float(w.w & 0xffff0000u);
                    s += ((y0 * y0 + y1 * y1) + (y2 * y2 + y3 * y3)) + ((y4 * y4 + y5 * y5) + (y6 * y6 + y7 * y7)); }
                s += __shfl_xor(s, 16); s += __shfl_xor(s, 32);
                if (fq == 0) PS[wc * 256 + ai * HALF + wr * 64 + m * 16 + fr] = s;
                asm volatile("" ::: "memory"); }
        asm volatile("s_waitcnt lgkmcnt(0)" ::: "memory"); __builtin_amdgcn_s_barrier(); asm volatile("" ::: "memory");
        const int tid = (wr * 4 + wc) * 64 + fq * 16 + fr;
        if (tid < 256) ssq_next[(size_t)(u.pm * BM + tid) * 4 + u.pn] = (PS[tid] + PS[256 + tid]) + (PS[512 + tid] + PS[768 + tid]);
    }
};
typedef float f32x2 __attribute__((ext_vector_type(2)));
__device__ __forceinline__ float gelu_tanh_(float x) { const float u = 1.5957691216057308f * (x + 0.044715f * x * x * x); return x * __builtin_amdgcn_rcpf(1.0f + __expf(-u)); }
struct EpiAct {
    static constexpr bool PERM = true, AFTER_DRAIN = false;
    bf16_t* ACT; const float* ssq; const float* cw; const float* cb; float* EU; float* EG; PG8_LAS float* HX;
    __device__ __forceinline__ void operator()(f32x4 (&acc)[2][2][4][2], const Unit& u, int wr_, int wc_, int fr_, int fq_) const {
        const int t_ = tid_now(), fr = t_ & 15, fq = (t_ >> 4) & 3, wc = (t_ >> 6) & 3, wr = t_ >> 8;
        const int lane = fq * 16 + fr;
        const int row0 = u.pm * BM + wr * 64 + fr, col0 = u.pn * HALF + wc * 32 + 8 * fq;
        f32x4 w0[2], w1[2], w2[2], bb[2];
#pragma unroll
        for (int n = 0; n < 2; ++n) { w0[n] = *(const f32x4*)(cw + col0 + 4 * n); w1[n] = *(const f32x4*)(cw + 2816 + col0 + 4 * n); w2[n] = *(const f32x4*)(cw + 2 * 2816 + col0 + 4 * n); bb[n] = *(const f32x4*)(cb + col0 + 4 * n); }
#pragma unroll
        for (int ai = 0; ai < 2; ++ai)
#pragma unroll
            for (int m = 0; m < 4; ++m) { const float rs = row_rstd(ssq, row0 + ai * HALF + m * 16);
#pragma unroll
                for (int bj = 0; bj < 2; ++bj) { acc[ai][bj][m][0] *= rs; acc[ai][bj][m][1] *= rs; } }
        if (fr >= 14) {
#pragma unroll
            for (int ai = 0; ai < 2; ++ai) { PG8_LAS float* hp = HX + ((((ai * 2 + wr) * 4 + wc) * 4 + fq) * 2 + (fr - 14)) * 8;
                *(PG8_LAS f32x4*)hp = acc[ai][0][3][0]; *(PG8_LAS f32x4*)(hp + 4) = acc[ai][0][3][1]; } }
        if (wr == 0 && fr < 2) { float* p = EU + ((size_t)(u.pm * 4 + fr)) * 2816 + col0; *(f32x4*)p = acc[0][0][0][0]; *(f32x4*)(p + 4) = acc[0][0][0][1];
            float* g = EG + ((size_t)(u.pm * 2 + fr)) * 2816 + col0; *(f32x4*)g = acc[0][1][0][0]; *(f32x4*)(g + 4) = acc[0][1][0][1]; }
        if (wr == 1 && fr >= 14) { float* p = EU + ((size_t)(u.pm * 4 + 2 + (fr - 14))) * 2816 + col0; *(f32x4*)p = acc[1][0][3][0]; *(f32x4*)(p + 4) = acc[1][0][3][1]; }
        asm volatile("s_waitcnt lgkmcnt(0)" ::: "memory"); __builtin_amdgcn_s_barrier(); asm volatile("" ::: "memory");
#pragma unroll
        for (int ai = 0; ai < 2; ++ai) {
            f32x4 pR1[2], pR2[2];
            { const int sai = wr ? ai : ai - 1, swr = wr ? 0 : 1;
              if (sai >= 0) { const PG8_LAS float* hp = HX + ((((sai * 2 + swr) * 4 + wc) * 4 + fq) * 2) * 8;
#pragma unroll
                  for (int n = 0; n < 2; ++n) { const f32x4 h14 = *(const PG8_LAS f32x4*)(hp + 4 * n), h15 = *(const PG8_LAS f32x4*)(hp + 8 + 4 * n); pR1[n] = h15; pR2[n] = (fr == 0) ? h14 : h15; } }
              else { pR1[0] = pR1[1] = pR2[0] = pR2[1] = (f32x4){0.f, 0.f, 0.f, 0.f}; } }
#pragma unroll
            for (int m = 0; m < 4; ++m) { u32x4 w;
#pragma unroll
                for (int n = 0; n < 2; ++n) { const f32x4 up = acc[ai][0][m][n], gt = acc[ai][1][m][n]; f32x4 av;
                    { f32x4 u1, u2;
#pragma unroll
                      for (int j = 0; j < 4; ++j) {
                          u1[j] = __int_as_float(__builtin_amdgcn_update_dpp(__float_as_int(pR1[n][j]), __float_as_int(up[j]), 0x111, 0xf, 0xf, false));
                          u2[j] = __int_as_float(__builtin_amdgcn_update_dpp(__float_as_int(pR2[n][j]), __float_as_int(up[j]), 0x112, 0xf, 0xf, false));
                          if (m < 3) { pR1[n][j] = __int_as_float(__builtin_amdgcn_update_dpp(0, __float_as_int(up[j]), 0x121, 0xf, 0xf, true));
                                       pR2[n][j] = __int_as_float(__builtin_amdgcn_update_dpp(0, __float_as_int(up[j]), 0x122, 0xf, 0xf, true)); } }
#pragma unroll
                      for (int hh = 0; hh < 2; ++hh) {
                          const f32x2 upv = {up[2 * hh], up[2 * hh + 1]}, u1v = {u1[2 * hh], u1[2 * hh + 1]}, u2v = {u2[2 * hh], u2[2 * hh + 1]}, gtv = {gt[2 * hh], gt[2 * hh + 1]};
                          const f32x2 bbv = {bb[n][2 * hh], bb[n][2 * hh + 1]}, w0v = {w0[n][2 * hh], w0[n][2 * hh + 1]}, w1v = {w1[n][2 * hh], w1[n][2 * hh + 1]}, w2v = {w2[n][2 * hh], w2[n][2 * hh + 1]};
                          const f32x2 c = bbv + w2v * upv + w1v * u1v + w0v * u2v;
                          const f32x2 arg = c * ((c * c) * (-0.10294324f) + (-2.3022082f));
                          f32x2 ex; ex.x = __builtin_amdgcn_exp2f(arg.x); ex.y = __builtin_amdgcn_exp2f(arg.y);
                          const f32x2 d = ex + 1.0f; f32x2 rc; rc.x = __builtin_amdgcn_rcpf(d.x); rc.y = __builtin_amdgcn_rcpf(d.y);
                          const f32x2 a2 = (c * rc) * gtv; av[2 * hh] = a2.x; av[2 * hh + 1] = a2.y; } }
                    if (n == 0) { w.x = cvt_pk_bf16(av[0], av[1]); w.y = cvt_pk_bf16(av[2], av[3]); } else { w.z = cvt_pk_bf16(av[0], av[1]); w.w = cvt_pk_bf16(av[2], av[3]); } }
                *(u32x4*)(ACT + (size_t)(row0 + ai * HALF + m * 16) * 2816 + col0) = w; }
        }
    }
};

template <class Epi, class Sched, bool ALIGN_EPI = false, bool SP2 = false>
__device__ __forceinline__ void gemm_phase(PG8_LAS unsigned char* lds, const Gemm g, const Sched& S, const Epi& E) {
    const int tid = tid_now(), wid = __builtin_amdgcn_readfirstlane(tid >> 6), lane = tid & 63, wr = wid >> 2, wc = wid & 3, fr = lane & 15, fq = lane >> 4;
    const int K = g.K, nt = K / BK;
    unsigned voffA[2], voffB[2];
#pragma unroll
    for (int i = 0; i < 2; ++i) { int R, C; stage_rc(tid * 16 + i * 8192, R, C); const int Rb = Epi::PERM ? ((R & ~31) + perm32(R & 31)) : R;
        voffA[i] = (unsigned)(R * K + C) * 2u; voffB[i] = (unsigned)(Rb * K + C) * 2u; }
    const size_t kstep = (size_t)(BK * 2);
    const size_t hstep = (size_t)HALF * K * 2;
    const size_t tstep = 2 * hstep;
    const unsigned ldsw = (unsigned)wid * 1024u;
    const int aoff = lds_byte(wr * 64 + fr, fq * 8), boff = lds_byte(wc * 32 + fr, fq * 8);
#define PG8_SA(b, h) (((b) * 2 + (h)) * HTB)
#define PG8_SB(b, h) ((4 + (b) * 2 + (h)) * HTB)
#define PG8_STAGE(bufoff, gbase, voff) do { _Pragma("unroll") for (int _i = 0; _i < 2; ++_i) \
        __builtin_amdgcn_global_load_lds((const unsigned*)((const char*)(gbase) + (voff)[_i]), (PG8_LAS unsigned*)(lds + (bufoff) + ldsw + _i * 8192), 16, 0, 0); } while (0)
#define PG8_LDA(dst, b, h) do { _Pragma("unroll") for (int m = 0; m < 4; ++m) _Pragma("unroll") for (int k = 0; k < 2; ++k) dst[m][k] = *(const PG8_LAS bf16x8*)(lds + PG8_SA(b, h) + aoff + m * 2048 + k * 1024); } while (0)
#define PG8_LDB(dst, b, h) do { _Pragma("unroll") for (int n = 0; n < 2; ++n) _Pragma("unroll") for (int k = 0; k < 2; ++k) dst[n][k] = *(const PG8_LAS bf16x8*)(lds + PG8_SB(b, h) + boff + n * 2048 + k * 1024); } while (0)
#define PG8_MMA(ai, bj, At, Bt) do { __builtin_amdgcn_s_setprio(1); _Pragma("unroll") for (int m = 0; m < 4; ++m) _Pragma("unroll") for (int n = 0; n < 2; ++n) _Pragma("unroll") for (int k = 0; k < 2; ++k) \
        acc[ai][bj][m][n] = __builtin_amdgcn_mfma_f32_16x16x32_bf16(Bt[n][k], At[m][k], acc[ai][bj][m][n], 0, 0, 0); __builtin_amdgcn_s_setprio(0); } while (0)
#define PG8_WAIT_V(n) asm volatile("s_waitcnt vmcnt(" #n ")" ::: "memory")
#define PG8_WAIT_L(n) asm volatile("s_waitcnt lgkmcnt(" #n ")" ::: "memory")
#define PG8_BAR __builtin_amdgcn_s_barrier()
#define PG8_SCHED __builtin_amdgcn_sched_barrier(0)
    Unit cur, nxt; int ui = 0;
    if (!S.next(0, cur)) return;
    f32x4 acc[2][2][4][2];
#pragma unroll
    for (int a = 0; a < 2; ++a)
#pragma unroll
        for (int b = 0; b < 2; ++b)
#pragma unroll
            for (int m = 0; m < 4; ++m)
#pragma unroll
                for (int n = 0; n < 2; ++n) acc[a][b][m][n] = (f32x4){0.f, 0.f, 0.f, 0.f};
    bf16x8 At[4][2], B0[2][2], B1[2][2];
    const char* cA = (const char*)g.A + (size_t)cur.pm * tstep; const char* cB = (const char*)g.Bt + (size_t)cur.pn * tstep;
    S.a_ready(cur);
    if constexpr (SP2) {
        PG8_STAGE(PG8_SB(0, 0), cB, voffB); PG8_STAGE(PG8_SB(0, 1), cB + hstep, voffB); PG8_STAGE(PG8_SA(0, 0), cA, voffA); PG8_STAGE(PG8_SA(0, 1), cA + hstep, voffA);
        if (wr == 1) PG8_BAR;
        PG8_WAIT_V(2); PG8_BAR;
        PG8_STAGE(PG8_SB(1, 0), cB + kstep, voffB); PG8_STAGE(PG8_SA(1, 0), cA + kstep, voffA); PG8_STAGE(PG8_SB(1, 1), cB + hstep + kstep, voffB);
        PG8_WAIT_V(6); PG8_BAR;
    } else {
        PG8_STAGE(PG8_SB(0, 0), cB, voffB); PG8_STAGE(PG8_SA(0, 0), cA, voffA); PG8_STAGE(PG8_SB(0, 1), cB + hstep, voffB); PG8_STAGE(PG8_SA(0, 1), cA + hstep, voffA);
        if (wr == 1) PG8_BAR;
        PG8_WAIT_V(4); PG8_BAR;
        PG8_STAGE(PG8_SB(1, 0), cB + kstep, voffB); PG8_STAGE(PG8_SA(1, 0), cA + kstep, voffA); PG8_STAGE(PG8_SB(1, 1), cB + hstep + kstep, voffB);
        PG8_WAIT_V(6); PG8_BAR;
    }
    for (;;) {
        const bool has_next = S.next(ui + 1, nxt);
        const char* nA = has_next ? (const char*)g.A + (size_t)nxt.pm * tstep : cA; const char* nB = has_next ? (const char*)g.Bt + (size_t)nxt.pn * tstep : cB;
        for (int t = 0; t < nt; t += 2) {
            const bool last = (t == nt - 2);
            const char* a1 = cA + (size_t)(t + 1) * kstep;
            const char* a2 = last ? nA : cA + (size_t)(t + 2) * kstep; const char* b2 = last ? nB : cB + (size_t)(t + 2) * kstep;
            const char* a3 = a2 + kstep; const char* b3 = b2 + kstep;
            if (last && has_next) S.a_ready(nxt);
            if constexpr (SP2) {
            PG8_LDB(B0, 0, 0); PG8_LDB(B1, 0, 1); PG8_SCHED; PG8_LDA(At, 0, 0); PG8_STAGE(PG8_SA(1, 1), a1 + hstep, voffA);
            PG8_WAIT_V(8); PG8_WAIT_L(0); PG8_BAR; PG8_MMA(0, 0, At, B0); PG8_MMA(0, 1, At, B1); PG8_BAR; PG8_SCHED;
            PG8_LDA(At, 0, 1); PG8_STAGE(PG8_SB(0, 0), b2, voffB); PG8_STAGE(PG8_SB(0, 1), b2 + hstep, voffB); PG8_STAGE(PG8_SA(0, 0), a2, voffA);
            PG8_WAIT_V(8); PG8_WAIT_L(0); PG8_BAR; PG8_MMA(1, 0, At, B0); PG8_MMA(1, 1, At, B1); PG8_BAR; PG8_SCHED;
            PG8_LDB(B0, 1, 0); PG8_LDB(B1, 1, 1); PG8_SCHED; PG8_LDA(At, 1, 0); PG8_STAGE(PG8_SA(0, 1), a2 + hstep, voffA);
            PG8_WAIT_V(8); PG8_WAIT_L(0); PG8_BAR; PG8_MMA(0, 0, At, B0); PG8_MMA(0, 1, At, B1); PG8_BAR; PG8_SCHED;
            PG8_LDA(At, 1, 1); PG8_STAGE(PG8_SB(1, 0), b3, voffB); PG8_STAGE(PG8_SB(1, 1), b3 + hstep, voffB); PG8_STAGE(PG8_SA(1, 0), a3, voffA);
            PG8_WAIT_V(8); PG8_WAIT_L(0); PG8_BAR; PG8_MMA(1, 0, At, B0); PG8_MMA(1, 1, At, B1); PG8_BAR; PG8_SCHED;
            } else {
            PG8_LDB(B0, 0, 0); PG8_SCHED; PG8_LDA(At, 0, 0); PG8_STAGE(PG8_SA(1, 1), a1 + hstep, voffA);
            PG8_WAIT_L(8); PG8_BAR; PG8_WAIT_L(0); PG8_MMA(0, 0, At, B0); PG8_BAR; PG8_SCHED;
            PG8_LDB(B1, 0, 1); PG8_STAGE(PG8_SB(0, 0), b2, voffB);
            PG8_BAR; PG8_WAIT_L(0); PG8_MMA(0, 1, At, B1); PG8_BAR;
            PG8_LDA(At, 0, 1); PG8_STAGE(PG8_SA(0, 0), a2, voffA);
            PG8_BAR; PG8_WAIT_L(0); PG8_MMA(1, 0, At, B0); PG8_BAR; PG8_SCHED;
            PG8_STAGE(PG8_SB(0, 1), b2 + hstep, voffB);
            PG8_WAIT_V(6); PG8_BAR; PG8_MMA(1, 1, At, B1); PG8_BAR;
            PG8_LDB(B0, 1, 0); PG8_SCHED; PG8_LDA(At, 1, 0); PG8_STAGE(PG8_SA(0, 1), a2 + hstep, voffA);
            PG8_WAIT_L(8); PG8_BAR; PG8_WAIT_L(0); PG8_MMA(0, 0, At, B0); PG8_BAR; PG8_SCHED;
            PG8_LDB(B1, 1, 1); PG8_STAGE(PG8_SB(1, 0), b3, voffB);
            PG8_BAR; PG8_WAIT_L(0); PG8_MMA(0, 1, At, B1); PG8_BAR;
            PG8_LDA(At, 1, 1); PG8_STAGE(PG8_SA(1, 0), a3, voffA);
            PG8_BAR; PG8_WAIT_L(0); PG8_MMA(1, 0, At, B0); PG8_BAR; PG8_SCHED;
            PG8_STAGE(PG8_SB(1, 1), b3 + hstep, voffB);
            PG8_WAIT_V(6); PG8_BAR; PG8_MMA(1, 1, At, B1); PG8_BAR;
            }
        }
        if constexpr (ALIGN_EPI) { if (wr == 0) PG8_BAR; }
        if constexpr (!Epi::AFTER_DRAIN) { E(acc, cur, wr, wc, fr, fq); S.done(cur); }
        if (!has_next) break;
#pragma unroll
        for (int a = 0; a < 2; ++a)
#pragma unroll
            for (int b = 0; b < 2; ++b)
#pragma unroll
                for (int m = 0; m < 4; ++m)
#pragma unroll
                    for (int n = 0; n < 2; ++n) acc[a][b][m][n] = (f32x4){0.f, 0.f, 0.f, 0.f};
        cur = nxt; cA = nA; cB = nB; ++ui;
        if constexpr (ALIGN_EPI) { if (wr == 1) PG8_BAR; }
    }
    PG8_WAIT_V(0);
    if constexpr (!ALIGN_EPI) { if (wr == 0) PG8_BAR; }
    PG8_BAR;
    if constexpr (Epi::AFTER_DRAIN) { E.fused(acc, cur, wr, wc, fr, fq, lds, wid, lane); S.done(cur); }
#undef PG8_SA
#undef PG8_SB
#undef PG8_STAGE
#undef PG8_LDA
#undef PG8_LDB
#undef PG8_MMA
#undef PG8_WAIT_V
#undef PG8_WAIT_L
#undef PG8_BAR
#undef PG8_SCHED
}
}

#define LAS __attribute__((address_space(3)))
typedef unsigned short bf16_t;
typedef short bf16x8 __attribute__((ext_vector_type(8)));
typedef float f32x4 __attribute__((ext_vector_type(4)));
typedef float f32x2 __attribute__((ext_vector_type(2)));
typedef unsigned u32x4 __attribute__((ext_vector_type(4)));
typedef unsigned u32x2 __attribute__((ext_vector_type(2)));

constexpr int T_TOK = 32768, DM = 1024, SEQL = 8192, FFD = 2816, ZW = 2560;
constexpr size_t ZB = (size_t)T_TOK * 128;
constexpr int LDS_BYTES = 156 * 1024;
constexpr size_t OFF_SSQ = 0;
constexpr size_t OFF_BAR = 524288;
constexpr size_t OFF_W   = 540672;
constexpr size_t W_IN = 0, W_OUT = 2621440, W_UG = 3670016, W_DN = 9437184, W_LAYER = 12320768;
constexpr size_t OFF_XG  = OFF_W + 4 * W_LAYER * 2;
constexpr size_t OFF_U   = OFF_XG + (size_t)T_TOK * DM * 2;
constexpr size_t OFF_G   = OFF_U + (size_t)T_TOK * FFD * 2;
constexpr size_t OFF_Y   = OFF_G;
constexpr size_t OFF_ST  = OFF_G + (size_t)T_TOK * DM * 2;
constexpr size_t OFF_GL  = OFF_ST + 33554432;
constexpr size_t OFF_EU  = OFF_U + (size_t)T_TOK * ZW * 2;
constexpr size_t OFF_EG  = OFF_EU + (size_t)128 * 4 * FFD * 4;
constexpr size_t WS_END  = OFF_G + (size_t)T_TOK * FFD * 2;

struct Args { const float* in[25]; float* out; unsigned char* ws; int ph_lo, ph_hi; };
typedef const __attribute__((address_space(4))) Args* KA;

__device__ __forceinline__ float bf_lo(unsigned w) { return __uint_as_float(w << 16); }
__device__ __forceinline__ float bf_hi(unsigned w) { return __uint_as_float(w & 0xffff0000u); }
__device__ __forceinline__ unsigned pk2(float lo, float hi) { return pg8::cvt_pk_bf16(lo, hi); }
__device__ __forceinline__ unsigned short f2bf(float f) { return (unsigned short)(pk2(f, 0.f) & 0xffffu); }
__device__ __forceinline__ void unpack8(const u32x4 w, float (&f)[8]) {
    f[0] = bf_lo(w.x); f[1] = bf_hi(w.x); f[2] = bf_lo(w.y); f[3] = bf_hi(w.y); f[4] = bf_lo(w.z); f[5] = bf_hi(w.z); f[6] = bf_lo(w.w); f[7] = bf_hi(w.w); }
__device__ __forceinline__ u32x4 pack8(const float (&f)[8]) { u32x4 w; w.x = pk2(f[0], f[1]); w.y = pk2(f[2], f[3]); w.z = pk2(f[4], f[5]); w.w = pk2(f[6], f[7]); return w; }
__device__ __forceinline__ float sigmoidf_(float x) { return __builtin_amdgcn_rcpf(1.0f + __expf(-x)); }
__device__ __forceinline__ float gelu_tanh(float x) { const float u = 1.5957691216057308f * (x + 0.044715f * x * x * x); return x * __builtin_amdgcn_rcpf(1.0f + __expf(-u)); }
#define MFMA16(a, b, c) __builtin_amdgcn_mfma_f32_16x16x32_bf16((a), (b), (c), 0, 0, 0)

#define XB_TMO      128
#define XB_XCNT(j)  (256  + 64 * (j))
#define XB_XSUB(j)  (1280 + 64 * (j))
#define XB_XGEN(j)  (2304 + 64 * (j))
#define XB_TOP      3328
#define XB_TOPGEN   3392
#define XCD_BAR_WORDS 3456
#define XB_SPIN_CAP (1u << 18)

__device__ __forceinline__ unsigned xb_ld(unsigned* p)              { return __hip_atomic_load(p, __ATOMIC_RELAXED, __HIP_MEMORY_SCOPE_AGENT); }
__device__ __forceinline__ unsigned xb_add(unsigned* p, unsigned v) { return __hip_atomic_fetch_add(p, v, __ATOMIC_RELAXED, __HIP_MEMORY_SCOPE_AGENT); }
__device__ __forceinline__ unsigned xb_xcc_id() { return (unsigned)__builtin_amdgcn_s_getreg((3 << 11) | 20) & 0xFu; }
#define XB_SPIN(cond, bar) do { unsigned _sp = 0; while (cond) { __builtin_amdgcn_s_sleep(1); \
    if ((++_sp & 255u) == 0u) { if (xb_ld(&(bar)[XB_TMO])) break; if (_sp > XB_SPIN_CAP) { atomicAdd(&(bar)[XB_TMO], 1u); break; } } } } while (0)

struct XcdBarrier {
    unsigned* bar; unsigned x;
    volatile LAS unsigned* st;
};

__device__ __forceinline__ XcdBarrier xcd_barrier_post(unsigned* bar, volatile LAS unsigned* st) {
    XcdBarrier b; b.bar = bar; b.x = xb_xcc_id(); b.st = st;
    if (threadIdx.x == 0) (void)xb_add(&bar[XB_XCNT(b.x)], 1u);
    return b;
}
__device__ __forceinline__ void xcd_barrier_complete(unsigned* bar, unsigned x, unsigned& nloc, unsigned& nx) {
    const unsigned G = gridDim.x * gridDim.y * gridDim.z;
    unsigned sum, cnt, mine, sp = 0u;
    for (;;) {
        sum = 0u; cnt = 0u; mine = 0u;
#pragma unroll
        for (unsigned j = 0; j < 16; ++j) { const unsigned c = xb_ld(&bar[XB_XCNT(j)]); sum += c; cnt += (c > 0u) ? 1u : 0u; mine = (j == x) ? c : mine; }
        if (sum == G) break;
        __builtin_amdgcn_s_sleep(1);
        if ((++sp & 255u) == 0u) { if (xb_ld(&bar[XB_TMO])) break; if (sp > XB_SPIN_CAP) { atomicAdd(&bar[XB_TMO], 1u); break; } }
    }
    nloc = mine > 0u ? mine : 1u; nx = cnt > 0u ? cnt : 1u;
}

__device__ __forceinline__ void xcd_barrier(const XcdBarrier& b) {
    asm volatile("s_waitcnt vmcnt(0)" ::: "memory");
    __syncthreads();
    if (threadIdx.x == 0) {
        unsigned* bar = b.bar;
        __builtin_amdgcn_s_waitcnt(0);
        unsigned nloc = b.st[0], nx = b.st[1];
        if (nloc == 0u) { xcd_barrier_complete(bar, b.x, nloc, nx); b.st[0] = nloc; b.st[1] = nx; }
        const unsigned old = xb_add(&bar[XB_XSUB(b.x)], 1u);
        const unsigned gen = old / nloc;
        if (old + 1u == (gen + 1u) * nloc) {
            __builtin_amdgcn_fence(__ATOMIC_RELEASE, "agent");
            asm volatile("s_waitcnt vmcnt(0)" ::: "memory");
            const unsigned og = xb_add(&bar[XB_TOP], 1u);
            const unsigned tg = og / nx;
            if (og + 1u == (tg + 1u) * nx) xb_add(&bar[XB_TOPGEN], 1u);
            else XB_SPIN(xb_ld(&bar[XB_TOPGEN]) == tg, bar);
            __builtin_amdgcn_fence(__ATOMIC_ACQUIRE, "agent");
            xb_add(&bar[XB_XGEN(b.x)], 1u);
            asm volatile("s_waitcnt vmcnt(0)" ::: "memory");
        } else {
            XB_SPIN(xb_ld(&bar[XB_XGEN(b.x)]) == gen, bar);
            __builtin_amdgcn_fence(__ATOMIC_ACQUIRE, "agent");
            asm volatile("s_waitcnt vmcnt(0)" ::: "memory");
        }
    }
    __syncthreads();
}


struct TJob { const float* src; const float* gain; bf16_t* dst; int Nsrc, k0, n0, K, mode; };
__device__ __forceinline__ TJob tjob_decode(KA a, int job) {
    TJob J; const int l = job / 752; int j = job - l * 752; const int hl = l >> 1;
    bf16_t* Wl = (bf16_t*)(a->ws + OFF_W) + (size_t)l * W_LAYER;
    if (j < 160) { J.src = ((l & 1) ? a->in[14] : a->in[4]) + (size_t)hl * 1024 * 2560; J.Nsrc = 2560; J.k0 = (j / 10) * 64; J.n0 = (j % 10) * 256; J.dst = Wl + W_IN; J.K = 1024; J.mode = 0; J.gain = a->in[1] + (size_t)l * 1024; return J; }
    j -= 160;
    if (j < 64) { J.src = ((l & 1) ? a->in[15] : a->in[5]) + (size_t)hl * 1024 * 1024; J.Nsrc = 1024; J.k0 = (j / 4) * 64; J.n0 = (j % 4) * 256; J.dst = Wl + W_OUT; J.K = 1024; J.mode = 0; J.gain = nullptr; return J; }
    j -= 64;
    if (j < 352) { const int gate = j >= 176; if (gate) j -= 176; J.src = (gate ? a->in[21] : a->in[20]) + (size_t)l * 1024 * 2816; J.Nsrc = 2816; J.k0 = (j / 11) * 64; J.n0 = (j % 11) * 256; J.dst = Wl + W_UG; J.K = 1024; J.mode = 1 + gate; J.gain = a->in[2] + (size_t)l * 1024; return J; }
    j -= 352;
    J.src = a->in[24] + (size_t)l * 2816 * 1024; J.Nsrc = 1024; J.k0 = (j / 4) * 64; J.n0 = (j % 4) * 256; J.dst = Wl + W_DN; J.K = 2816; J.mode = 0; J.gain = nullptr; return J;
}
__device__ __forceinline__ void tjob_load(const TJob& J, int tid, f32x4 (&v)[4][2], float& g0, float& g1) {
    const int kk = tid >> 4, n4 = (tid & 15) * 4;
#pragma unroll
    for (int s = 0; s < 4; ++s)
#pragma unroll
        for (int p = 0; p < 2; ++p) v[s][p] = *(const f32x4*)(J.src + (size_t)(J.k0 + kk + 32 * p) * J.Nsrc + J.n0 + 64 * s + n4);
    g0 = 1.f; g1 = 1.f; if (J.gain) { g0 = J.gain[J.k0 + kk]; g1 = J.gain[J.k0 + kk + 32]; }
}
__device__ __forceinline__ void phase_prologue(KA a, LAS unsigned char* lds) {
    const int tid = tid_now(), G = gridDim.x, bx = blockIdx.x;
    float* ssq = (float*)(a->ws + OFF_SSQ);
    LAS unsigned short* tile = (LAS unsigned short*)lds;
    {
      constexpr int NJ = 4 * 752; int job = bx; f32x4 v[4][2]; float g0 = 1.f, g1 = 1.f; TJob J = tjob_decode(a, job < NJ ? job : 0);
      if (job < NJ) tjob_load(J, tid, v, g0, g1);
      const int kk = tid >> 4, n4 = (tid & 15) * 4, n = tid >> 3, k8 = (tid & 7) * 8;
      while (job < NJ) {
#pragma unroll
          for (int s = 0; s < 4; ++s)
#pragma unroll
              for (int p = 0; p < 2; ++p) { const f32x4 w = v[s][p] * (p ? g1 : g0); LAS unsigned short* tp = tile + s * 4608 + n4 * 72 + kk + 32 * p;
                  tp[0] = f2bf(w[0]); tp[72] = f2bf(w[1]); tp[144] = f2bf(w[2]); tp[216] = f2bf(w[3]); }
          bf16_t* const cdst = J.dst; const int cK = J.K, ck0 = J.k0, cn0 = J.n0, cmode = J.mode;
          const int nj = job + G;
          if (nj < NJ) { J = tjob_decode(a, nj); tjob_load(J, tid, v, g0, g1); }
          __syncthreads();
#pragma unroll
          for (int s = 0; s < 4; ++s) { const int nn = cn0 + 64 * s + n; const int drow = cmode ? ((nn >> 7) * 256 + (nn & 127) + (cmode - 1) * 128) : nn;
              *(u32x4*)(cdst + (size_t)drow * cK + ck0 + k8) = *(const LAS u32x4*)(tile + s * 4608 + n * 72 + k8); }
          __syncthreads();
          job = nj;
      }
    }
    const int lane = tid & 63, wave = tid >> 6;
    const float* x = a->in[0]; bf16_t* xg = (bf16_t*)(a->ws + OFF_XG);
    { const int STEP = G * 8 * 4; int row0 = bx * 8 + wave; f32x4 v[4][4];
#pragma unroll
      for (int rr = 0; rr < 4; ++rr)
#pragma unroll
          for (int i = 0; i < 4; ++i) { const int rw = (row0 + rr * G * 8 < T_TOK) ? row0 + rr * G * 8 : T_TOK - 1; v[rr][i] = *(const f32x4*)(x + (size_t)rw * 1024 + lane * 4 + 256 * i); }
      for (; row0 < T_TOK; row0 += STEP) {
        f32x4 vn[4][4]; const int nr0 = row0 + STEP;
#pragma unroll
        for (int rr = 0; rr < 4; ++rr)
#pragma unroll
            for (int i = 0; i < 4; ++i) { const int rw = (nr0 + rr * G * 8 < T_TOK) ? nr0 + rr * G * 8 : T_TOK - 1; vn[rr][i] = *(const f32x4*)(x + (size_t)rw * 1024 + lane * 4 + 256 * i); }
#pragma unroll
        for (int rr = 0; rr < 4; ++rr) { const int row = row0 + rr * G * 8; float s = 0.f; if (row >= T_TOK) continue;
#pragma unroll
            for (int i = 0; i < 4; ++i) { u32x2 w; w.x = pk2(v[rr][i][0], v[rr][i][1]); w.y = pk2(v[rr][i][2], v[rr][i][3]); *(u32x2*)(xg + (size_t)row * 1024 + lane * 4 + 256 * i) = w;
                const float y0 = bf_lo(w.x), y1 = bf_hi(w.x), y2 = bf_lo(w.y), y3 = bf_hi(w.y); s += (y0 * y0 + y1 * y1) + (y2 * y2 + y3 * y3); }
#pragma unroll
            for (int o = 32; o >= 1; o >>= 1) s += __shfl_xor(s, o);
            if (lane < 4) ssq[(size_t)row * 4 + lane] = (lane == 0) ? s : 0.f; }
#pragma unroll
        for (int rr = 0; rr < 4; ++rr)
#pragma unroll
            for (int i = 0; i < 4; ++i) v[rr][i] = vn[rr][i];
      } }
}

constexpr int LR_BB = 0, LR_AA = 34816, LR_XB = 69632, LR_WT = 88064, LR_XH = 106496, LR_SEG = 125440, LR_FOLD = 129536, LR_CW = 133632;
__device__ __forceinline__ void lru_load_xh(KA a, int unit, int tid, u32x4 (&pf)[3]) {
    const int h = unit & 7, c = (unit >> 3) & 63, b = unit >> 9; const bf16_t* Z = (const bf16_t*)(a->ws + OFF_U);
#pragma unroll
    for (int k = 0; k < 3; ++k) { const int idx = tid + 512 * k, r = idx >> 3, c8 = (idx & 7) * 8, pos = c * 128 - 3 + r;
        u32x4 w = {0u, 0u, 0u, 0u}; if (idx < 131 * 8 && pos >= 0) w = *(const u32x4*)(Z + (size_t)(h >> 1) * ZB + ((size_t)b * SEQL + pos) * 128 + (h & 1) * 64 + c8);
        pf[k] = w; }
}
__device__ __forceinline__ void lru_unit(KA a, LAS unsigned char* lds, int e, int unit, int pass, bool stage_w, u32x4 (&pf)[3], int next_unit) {
    const int tid = tid_now(), lane = tid & 63, wave = tid >> 6;
    const int h = unit & 7, c = (unit >> 3) & 63, b = unit >> 9;
    const bf16_t* Z = (const bf16_t*)(a->ws + OFF_U);
    f32x2* AGG = (f32x2*)(a->ws + OFF_ST);
    LAS float* BB = (LAS float*)(lds + LR_BB); LAS float* AA = (LAS float*)(lds + LR_AA);
    LAS unsigned short* XB = (LAS unsigned short*)(lds + LR_XB); LAS unsigned short* WT = (LAS unsigned short*)(lds + LR_WT);
    LAS unsigned short* XH = (LAS unsigned short*)(lds + LR_XH);
    LAS f32x2* SEG = (LAS f32x2*)(lds + LR_SEG); LAS f32x2* FOLD = (LAS f32x2*)(lds + LR_FOLD);
    const size_t tok0 = (size_t)b * SEQL + (size_t)c * 128;
    const int ch = tid & 63, seg = tid >> 6;
    const size_t aggbase = ((size_t)b * 64) * 512 + h * 64 + ch;
    f32x2 ag[8]; u32x4 gaw0 = {0u, 0u, 0u, 0u}, gaw1 = {0u, 0u, 0u, 0u};
    if (pass == 2) {
#pragma unroll
        for (int i = 0; i < 8; ++i) ag[i] = AGG[aggbase + (size_t)(seg * 8 + i) * 512];
        const bf16_t* gap = Z + (size_t)(4 + (h >> 1)) * ZB + (tok0 + (tid >> 2)) * 128 + (h & 1) * 64 + (tid & 3) * 16; gaw0 = *(const u32x4*)gap; gaw1 = *(const u32x4*)(gap + 8); }
    float wv[16]; float cv = 0.f;
    if (stage_w) { const float* wa = a->in[8] + (size_t)e * 32768 + h * 4096; const float* wi = a->in[10] + (size_t)e * 32768 + h * 4096;
#pragma unroll
      for (int k = 0; k < 16; ++k) { const int idx = tid + 512 * k; wv[k] = ((idx >> 12) ? wi : wa)[idx & 4095]; }
      const int grp = tid >> 6, cch = tid & 63;
      if (grp < 4) cv = a->in[6][(size_t)e * 2048 + grp * 512 + h * 64 + cch];
      else if (grp == 4) cv = a->in[7][(size_t)e * 512 + h * 64 + cch];
      else if (grp == 5) cv = a->in[9][(size_t)e * 512 + h * 64 + cch];
      else if (grp == 6) cv = a->in[11][(size_t)e * 512 + h * 64 + cch];
      else cv = a->in[12][(size_t)e * 512 + h * 64 + cch]; }
#pragma unroll
    for (int k = 0; k < 3; ++k) { const int idx = tid + 512 * k; if (idx < 131 * 8) *(LAS u32x4*)(XH + (idx >> 3) * 72 + (idx & 7) * 8) = pf[k]; }
    if (stage_w) {
#pragma unroll
      for (int k = 0; k < 16; ++k) { const int idx = tid + 512 * k, gate = idx >> 12, rem = idx & 4095, i = rem >> 6, j = rem & 63; WT[(gate * 64 + j) * 72 + i] = f2bf(wv[k]); }
      LAS float* CWs = (LAS float*)(lds + LR_CW);
      CWs[tid] = ((tid >> 6) == 7) ? __logf(1.0f + __expf(-cv)) : cv; }
    __syncthreads();
    { const int t = tid >> 2, c16 = (tid & 3) * 16;
      const LAS float* cw = (const LAS float*)(lds + LR_CW) + c16; const LAS float* cb = cw + 256;
      float xc[16];
#pragma unroll
      for (int i = 0; i < 4; ++i) { const f32x4 v = *(const LAS f32x4*)(cb + 4 * i); xc[4 * i] = v[0]; xc[4 * i + 1] = v[1]; xc[4 * i + 2] = v[2]; xc[4 * i + 3] = v[3]; }
#pragma unroll
      for (int j = 0; j < 4; ++j) {
          float xv[16]; { float t8[8]; unpack8(*(const LAS u32x4*)(XH + (t + j) * 72 + c16), t8);
#pragma unroll
              for (int i = 0; i < 8; ++i) xv[i] = t8[i];
              unpack8(*(const LAS u32x4*)(XH + (t + j) * 72 + c16 + 8), t8);
#pragma unroll
              for (int i = 0; i < 8; ++i) xv[8 + i] = t8[i]; }
#pragma unroll
          for (int i = 0; i < 4; ++i) { const f32x4 w = *(const LAS f32x4*)(cw + j * 64 + 4 * i);
              xc[4 * i] += w[0] * xv[4 * i]; xc[4 * i + 1] += w[1] * xv[4 * i + 1]; xc[4 * i + 2] += w[2] * xv[4 * i + 2]; xc[4 * i + 3] += w[3] * xv[4 * i + 3]; }
      }
#pragma unroll
      for (int i = 0; i < 4; ++i) *(LAS f32x4*)(BB + t * 68 + c16 + 4 * i) = (f32x4){xc[4 * i], xc[4 * i + 1], xc[4 * i + 2], xc[4 * i + 3]};
      u32x4 w0, w1; w0.x = pk2(xc[0], xc[1]); w0.y = pk2(xc[2], xc[3]); w0.z = pk2(xc[4], xc[5]); w0.w = pk2(xc[6], xc[7]);
      w1.x = pk2(xc[8], xc[9]); w1.y = pk2(xc[10], xc[11]); w1.z = pk2(xc[12], xc[13]); w1.w = pk2(xc[14], xc[15]);
      *(LAS u32x4*)(XB + t * 72 + c16) = w0; *(LAS u32x4*)(XB + t * 72 + c16 + 8) = w1; }
    __syncthreads();
    if (next_unit >= 0) lru_load_xh(a, next_unit, tid, pf);
    { const int r = lane & 15, q = lane >> 4, tb = wave;
      const bf16x8 a0 = *(const LAS bf16x8*)(XB + (tb * 16 + r) * 72 + q * 8), a1 = *(const LAS bf16x8*)(XB + (tb * 16 + r) * 72 + 32 + q * 8);
      const LAS float* ba = (const LAS float*)(lds + LR_CW) + 320; const LAS float* bi = ba + 64; const LAS float* spv = ba + 128;
#pragma unroll
      for (int cb = 0; cb < 4; ++cb) {
          const bf16x8 bA0 = *(const LAS bf16x8*)(WT + (cb * 16 + r) * 72 + q * 8), bA1 = *(const LAS bf16x8*)(WT + (cb * 16 + r) * 72 + 32 + q * 8);
          const bf16x8 bI0 = *(const LAS bf16x8*)(WT + (64 + cb * 16 + r) * 72 + q * 8), bI1 = *(const LAS bf16x8*)(WT + (64 + cb * 16 + r) * 72 + 32 + q * 8);
          f32x4 cA = {0.f, 0.f, 0.f, 0.f}, cI = {0.f, 0.f, 0.f, 0.f};
          cA = MFMA16(a0, bA0, cA); cA = MFMA16(a1, bA1, cA); cI = MFMA16(a0, bI0, cI); cI = MFMA16(a1, bI1, cI);
          const int ch = cb * 16 + r; const float bav = ba[ch], biv = bi[ch], sp = spv[ch];
#pragma unroll
          for (int j2 = 0; j2 < 2; ++j2) {
              const int t0 = tb * 16 + q * 4 + 2 * j2;
              const f32x2 xa = {cA[2 * j2] + bav, cA[2 * j2 + 1] + bav}, xi = {cI[2 * j2] + biv, cI[2 * j2 + 1] + biv};
              const f32x2 ea = xa * (-1.44269504f), ei = xi * (-1.44269504f);
              f32x2 da, di; da.x = 1.0f + __builtin_amdgcn_exp2f(ea.x); da.y = 1.0f + __builtin_amdgcn_exp2f(ea.y); di.x = 1.0f + __builtin_amdgcn_exp2f(ei.x); di.y = 1.0f + __builtin_amdgcn_exp2f(ei.y);
              f32x2 ra, ig; ra.x = __builtin_amdgcn_rcpf(da.x); ra.y = __builtin_amdgcn_rcpf(da.y); ig.x = __builtin_amdgcn_rcpf(di.x); ig.y = __builtin_amdgcn_rcpf(di.y);
              const f32x2 l2 = ra * (-8.0f * 1.44269504f * sp);
              f32x2 av; av.x = __builtin_amdgcn_exp2f(l2.x); av.y = __builtin_amdgcn_exp2f(l2.y);
              f32x2 om = 1.0f - av * av; om.x = fmaxf(om.x, 1e-30f); om.y = fmaxf(om.y, 1e-30f);
              f32x2 rq; rq.x = __builtin_amdgcn_rsqf(om.x); rq.y = __builtin_amdgcn_rsqf(om.y);
              f32x2 mult = om * rq;
              if (c == 0 && t0 == 0) mult.x = 1.0f;
              const f32x2 xcv = {BB[t0 * 68 + ch], BB[(t0 + 1) * 68 + ch]};
              const f32x2 bv = (mult * ig) * xcv;
              AA[t0 * 68 + ch] = av.x; AA[(t0 + 1) * 68 + ch] = av.y; BB[t0 * 68 + ch] = bv.x; BB[(t0 + 1) * 68 + ch] = bv.y; }
      } }
    __syncthreads();
    { float hh = 0.f, P = 1.f;
#pragma unroll 4
      for (int i = 0; i < 16; ++i) { const int t = seg * 16 + i; const float av = AA[t * 68 + ch], bv = BB[t * 68 + ch]; hh = av * hh + bv; P *= av; BB[t * 68 + ch] = hh; AA[t * 68 + ch] = P; }
      SEG[seg * 64 + ch] = (f32x2){P, hh}; }
    if (pass == 1) {
        __syncthreads();
        if (tid < 64) { float P = 1.f, hh = 0.f;
#pragma unroll
            for (int s = 0; s < 8; ++s) { const f32x2 sg = SEG[s * 64 + ch]; hh = sg.x * hh + sg.y; P *= sg.x; }
            AGG[aggbase + (size_t)c * 512] = (f32x2){P, hh}; }
        __syncthreads();
        return;
    }
    { float P = 1.f, hh = 0.f;
#pragma unroll
      for (int i = 0; i < 8; ++i) { const int cc = seg * 8 + i; const bool use = cc < c; const float p = use ? ag[i].x : 1.f, q = use ? ag[i].y : 0.f; hh = p * hh + q; P *= p; }
      FOLD[seg * 64 + ch] = (f32x2){P, hh}; }
    __syncthreads();
    { float hin = 0.f;
#pragma unroll
      for (int s = 0; s < 8; ++s) { const f32x2 f = FOLD[s * 64 + ch]; hin = f.x * hin + f.y; }
#pragma unroll
      for (int s = 0; s < 8; ++s) { if (s < seg) { const f32x2 sg = SEG[s * 64 + ch]; hin = sg.x * hin + sg.y; } }
#pragma unroll 4
      for (int i = 0; i < 16; ++i) { const int t = seg * 16 + i; BB[t * 68 + ch] += AA[t * 68 + ch] * hin; } }
    __syncthreads();
    { const int t = tid >> 2, c16 = (tid & 3) * 16; bf16_t* Y = (bf16_t*)(a->ws + OFF_Y);
      float g0[8], g1[8]; unpack8(gaw0, g0); unpack8(gaw1, g1);
      float y0[8], y1[8];
#pragma unroll
      for (int i4 = 0; i4 < 2; ++i4) { const f32x4 hA = *(const LAS f32x4*)(BB + t * 68 + c16 + 4 * i4), hB = *(const LAS f32x4*)(BB + t * 68 + c16 + 8 + 4 * i4);
#pragma unroll
          for (int j = 0; j < 4; ++j) { y0[4 * i4 + j] = hA[j] * gelu_tanh(g0[4 * i4 + j]); y1[4 * i4 + j] = hB[j] * gelu_tanh(g1[4 * i4 + j]); } }
      bf16_t* yp = Y + (tok0 + t) * 1024 + h * 64 + c16;
      *(u32x4*)yp = pack8(y0); *(u32x4*)(yp + 8) = pack8(y1); }
    __syncthreads();
}
__device__ __forceinline__ void sconv_unit(KA a, int e, int unit) {
    const int tid = tid_now(), c8 = (tid & 63) * 8, tt = tid >> 6;
    const bf16_t* Z = (const bf16_t*)(a->ws + OFF_U); bf16_t* Y = (bf16_t*)(a->ws + OFF_Y);
    const float* sw = a->in[13] + (size_t)e * 1536 + c8;
    float w[3][8];
#pragma unroll
    for (int j = 0; j < 3; ++j) { const f32x4 v0 = *(const f32x4*)(sw + j * 512), v1 = *(const f32x4*)(sw + j * 512 + 4);
        w[j][0] = v0[0]; w[j][1] = v0[1]; w[j][2] = v0[2]; w[j][3] = v0[3]; w[j][4] = v1[0]; w[j][5] = v1[1]; w[j][6] = v1[2]; w[j][7] = v1[3]; }
    const bf16_t* zb = Z + (size_t)(c8 >> 7) * ZB + (c8 & 127);
    u32x4 hbw[4][3], cgw[4][3], bgw[4];
#pragma unroll
    for (int rr = 0; rr < 4; ++rr) { const int tok = unit * 32 + rr * 8 + tt, pos = tok & (SEQL - 1);
#pragma unroll
        for (int j = 0; j < 3; ++j) { const int d = 2 - j; const bf16_t* zr = zb + (size_t)((pos >= d) ? tok - d : tok) * 128;
            hbw[rr][j] = *(const u32x4*)(zr + 8 * ZB); cgw[rr][j] = *(const u32x4*)(zr + 16 * ZB); }
        bgw[rr] = *(const u32x4*)(zb + 12 * ZB + (size_t)tok * 128); }
#pragma unroll
    for (int rr = 0; rr < 4; ++rr) { const int tok = unit * 32 + rr * 8 + tt, pos = tok & (SEQL - 1);
        float acc[8];
#pragma unroll
        for (int i = 0; i < 8; ++i) acc[i] = 0.f;
#pragma unroll
        for (int j = 0; j < 3; ++j) { const float msk = (pos >= 2 - j) ? 1.0f : 0.0f; float hb[8], cgv[8]; unpack8(hbw[rr][j], hb); unpack8(cgw[rr][j], cgv);
#pragma unroll
            for (int i = 0; i < 8; ++i) acc[i] += (w[j][i] * msk) * (cgv[i] * hb[i]); }
        float bg[8]; unpack8(bgw[rr], bg);
#pragma unroll
        for (int i = 0; i < 8; ++i) acc[i] *= bg[i];
        *(u32x4*)(Y + (size_t)tok * 1024 + 512 + c8) = pack8(acc);
    }
}

constexpr int PL_UH = 0, PL_PA = 38912, PL_WT = 73728;
__device__ __forceinline__ void pool_load_uh(KA a, int unit, int tid, u32x4 (&pf)[5]) {
    const int g = unit & 3, tile = unit >> 2; const int tok0 = tile * 128, pos0 = tok0 & (SEQL - 1); const bf16_t* Z = (const bf16_t*)(a->ws + OFF_U);
#pragma unroll
    for (int k = 0; k < 5; ++k) { const int idx = tid + 512 * k, r = idx >> 4, c8 = (idx & 15) * 8, pos = pos0 - 15 + r;
        u32x4 w = {0u, 0u, 0u, 0u}; if (idx < 143 * 16 && pos >= 0) w = *(const u32x4*)(Z + (size_t)g * ZB + (size_t)(tok0 - 15 + r) * 128 + c8);
        pf[k] = w; }
}
__device__ __forceinline__ void pool_unit(KA a, LAS unsigned char* lds, int o, int unit, bool stage_w, u32x4 (&pf)[5], int next_unit) {
    const int tid = tid_now(), lane = tid & 63, wave = tid >> 6;
    const int g = unit & 3, tile = unit >> 2; const int tok0 = tile * 128, pos0 = tok0 & (SEQL - 1);
    const bf16_t* Z = (const bf16_t*)(a->ws + OFF_U); bf16_t* Y = (bf16_t*)(a->ws + OFF_Y);
    LAS unsigned short* UH = (LAS unsigned short*)(lds + PL_UH); LAS unsigned short* PA = (LAS unsigned short*)(lds + PL_PA); LAS unsigned short* WT = (LAS unsigned short*)(lds + PL_WT);
#pragma unroll
    for (int k = 0; k < 5; ++k) { const int idx = tid + 512 * k; if (idx < 143 * 16) *(LAS u32x4*)(UH + (idx >> 4) * 136 + (idx & 15) * 8) = pf[k]; }
    if (stage_w) { const float* pw = a->in[16] + (size_t)o * 65536 + g * 16384;
#pragma unroll
      for (int kb = 0; kb < 2; ++kb) { float wv[16];
#pragma unroll
          for (int k = 0; k < 16; ++k) wv[k] = pw[tid + 512 * (kb * 16 + k)];
#pragma unroll
          for (int k = 0; k < 16; ++k) { const int idx = tid + 512 * (kb * 16 + k), i = idx >> 7, oo = idx & 127; WT[oo * 136 + i] = f2bf(wv[k]); } } }
    __syncthreads();
    {
      const int c8 = (tid & 15) * 8, tg = (tid >> 4) * 4; const int win = 2 << g;
      float s[8];
#pragma unroll
      for (int i = 0; i < 8; ++i) s[i] = 0.f;
      for (int k = 0; k < win; ++k) { float v[8]; unpack8(*(const LAS u32x4*)(UH + (tg + 15 - k) * 136 + c8), v);
#pragma unroll
          for (int i = 0; i < 8; ++i) s[i] += v[i]; }
#pragma unroll
      for (int tt = 0; tt < 4; ++tt) { const int t = tg + tt; float u0[8]; unpack8(*(const LAS u32x4*)(UH + (t + 15) * 136 + c8), u0);
          if (tt > 0) { float ul[8]; unpack8(*(const LAS u32x4*)(UH + (t + 15 - win) * 136 + c8), ul);
#pragma unroll
              for (int i = 0; i < 8; ++i) s[i] += u0[i] - ul[i]; }
          const int pos = pos0 + t; const int n = (pos + 1 < win) ? pos + 1 : win; const float inv = __builtin_amdgcn_rcpf((float)n);
          float p[8];
#pragma unroll
          for (int i = 0; i < 8; ++i) p[i] = s[i] * inv - u0[i];
          *(LAS u32x4*)(PA + t * 136 + c8) = pack8(p); } }
    __syncthreads();
    if (next_unit >= 0) pool_load_uh(a, next_unit, tid, pf);
    { const int r = lane & 15, q = lane >> 4, tb = wave;
      bf16x8 af[4];
#pragma unroll
      for (int ks = 0; ks < 4; ++ks) af[ks] = *(const LAS bf16x8*)(PA + (tb * 16 + r) * 136 + ks * 32 + q * 8);
      const float* sc = a->in[17] + (size_t)o * 512 + g * 128;
#pragma unroll
      for (int ob = 0; ob < 8; ++ob) { f32x4 cc = {0.f, 0.f, 0.f, 0.f};
#pragma unroll
          for (int ks = 0; ks < 4; ++ks) cc = MFMA16(af[ks], *(const LAS bf16x8*)(WT + (ob * 16 + r) * 136 + ks * 32 + q * 8), cc);
          const float s = sc[ob * 16 + r];
#pragma unroll
          for (int jj = 0; jj < 4; ++jj) PA[(tb * 16 + q * 4 + jj) * 136 + ob * 16 + r] = f2bf(cc[jj] * s); }
      { const int rr = lane >> 2, c32 = (lane & 3) * 32;
#pragma unroll
        for (int k = 0; k < 4; ++k) *(u32x4*)(Y + (size_t)(tok0 + tb * 16 + rr) * 1024 + g * 128 + c32 + 8 * k) = *(const LAS u32x4*)(PA + (tb * 16 + rr) * 136 + c32 + 8 * k); } }
    __syncthreads();
}

constexpr int HG_QT = 0, HG_KT = 17408, HG_QP = 34816, HG_KTT = 52224, HG_VT = 70656, HG_AM = 89088, HG_SB = 98304, HG_DL = 133120, HG_EL = 133632, HG_LB = 134144, HG_GLS = 134656, HG_NG = 135168;
__device__ __forceinline__ float wave_scan_incl(float x) {
    x += __int_as_float(__builtin_amdgcn_update_dpp(0, __float_as_int(x), 0x111, 0xf, 0xf, true));
    x += __int_as_float(__builtin_amdgcn_update_dpp(0, __float_as_int(x), 0x112, 0xf, 0xf, true));
    x += __int_as_float(__builtin_amdgcn_update_dpp(0, __float_as_int(x), 0x114, 0xf, 0xf, true));
    x += __int_as_float(__builtin_amdgcn_update_dpp(0, __float_as_int(x), 0x118, 0xf, 0xf, true));
    x += __int_as_float(__builtin_amdgcn_update_dpp(0, __float_as_int(x), 0x142, 0xa, 0xf, false));
    x += __int_as_float(__builtin_amdgcn_update_dpp(0, __float_as_int(x), 0x143, 0xc, 0xf, false));
    return x;
}
__device__ __forceinline__ void hgrn_load_first(KA a, int unit, int tid, int pass, u32x4 (&nx)[6]) {
    const int lane = tid & 63, wave = tid >> 6, h = unit & 3, blk = (unit >> 2) & 31, b = unit >> 7;
    const bf16_t* zl = (const bf16_t*)(a->ws + OFF_U) + (size_t)h * ZB + ((size_t)b * SEQL + blk * 256 + lane) * 128 + wave * 16;
    nx[0] = *(const u32x4*)(zl + 8 * ZB); nx[1] = *(const u32x4*)(zl + 8 * ZB + 8); nx[2] = *(const u32x4*)(zl + 12 * ZB); nx[3] = *(const u32x4*)(zl + 12 * ZB + 8);
    if (pass == 2) { nx[4] = *(const u32x4*)(zl + 4 * ZB); nx[5] = *(const u32x4*)(zl + 4 * ZB + 8); } else { nx[4] = (u32x4){0u, 0u, 0u, 0u}; nx[5] = (u32x4){0u, 0u, 0u, 0u}; }
}
__device__ __forceinline__ void hgrn_unit(KA a, LAS unsigned char* lds, int o, int unit, int pass, u32x4 (&nx)[6], int next_unit) {
    const int tid = tid_now(), lane = tid & 63, wave = tid >> 6, r = lane & 15, q = lane >> 4;
    const int h = unit & 3, blk = (unit >> 2) & 31, b = unit >> 7;
    const bf16_t* Z = (const bf16_t*)(a->ws + OFF_U); bf16_t* Y = (bf16_t*)(a->ws + OFF_Y);
    float* DS = (float*)(a->ws + OFF_ST) + ((size_t)((b * 32 + blk) * 4 + h)) * 16384;
    float* GLB = (float*)(a->ws + OFF_GL) + ((size_t)((b * 32 + blk) * 4 + h)) * 128;
    LAS float* Os = (LAS float*)(lds + HG_QT);
    LAS unsigned short* QT = (LAS unsigned short*)(lds + HG_QT); LAS unsigned short* KT = (LAS unsigned short*)(lds + HG_KT); LAS unsigned short* QP = (LAS unsigned short*)(lds + HG_QP);
    LAS unsigned short* KTT = (LAS unsigned short*)(lds + HG_KTT); LAS unsigned short* VT = (LAS unsigned short*)(lds + HG_VT);
    LAS unsigned short* AM = (LAS unsigned short*)(lds + HG_AM); LAS unsigned short* SB = (LAS unsigned short*)(lds + HG_SB);
    LAS float* DL = (LAS float*)(lds + HG_DL); LAS float* EL = (LAS float*)(lds + HG_EL); LAS float* LBS = (LAS float*)(lds + HG_LB); LAS float* GLS = (LAS float*)(lds + HG_GLS); LAS float* NGS = (LAS float*)(lds + HG_NG);
    const int t = tid >> 3, d0 = (tid & 7) * 16;
    if (tid < 128) { float v = 0.f; if (o == 1) { const float l0 = a->in[18][h * 128 + tid], l1 = a->in[18][512 + h * 128 + tid]; v = 1.0f / (1.0f + __expf(l0 - l1)); } LBS[tid] = 1.0f - v; GLS[tid] = 0.f; NGS[tid] = a->in[19][(size_t)o * 512 + h * 128 + tid]; }
    __syncthreads();
    f32x4 St[8];
#pragma unroll
    for (int kb = 0; kb < 8; ++kb) { if (pass == 2) {
#pragma unroll
            for (int jj = 0; jj < 4; ++jj) St[kb][jj] = DS[(wave * 16 + q * 4 + jj) * 128 + kb * 16 + r]; } else St[kb] = (f32x4){0.f, 0.f, 0.f, 0.f}; }
    const bf16_t* zl = Z + (size_t)h * ZB + ((size_t)b * SEQL + blk * 256 + lane) * 128 + wave * 16;
    u32x4 nfw0 = nx[0], nfw1 = nx[1], nvw0 = nx[2], nvw1 = nx[3], nqw0 = nx[4], nqw1 = nx[5];
    const int tsw = (((lane >> 3) ^ wave) << 3) + (lane & 7);
    for (int s = 0; s < 4; ++s) {
        const size_t row = (size_t)b * SEQL + blk * 256 + s * 64 + t;
        const u32x4 fw0 = nfw0, fw1 = nfw1, qw0 = nqw0, qw1 = nqw1, vw0 = nvw0, vw1 = nvw1;
        if (s < 3) { const bf16_t* zn = zl + (size_t)(s + 1) * 64 * 128;
            nfw0 = *(const u32x4*)(zn + 8 * ZB); nfw1 = *(const u32x4*)(zn + 8 * ZB + 8); nvw0 = *(const u32x4*)(zn + 12 * ZB); nvw1 = *(const u32x4*)(zn + 12 * ZB + 8);
            if (pass == 2) { nqw0 = *(const u32x4*)(zn + 4 * ZB); nqw1 = *(const u32x4*)(zn + 4 * ZB + 8); } }
        else if (next_unit >= 0) hgrn_load_first(a, next_unit, tid, pass, nx);
#pragma unroll 1
        for (int hv = 0; hv < 2; ++hv) { const int dd = wave * 16 + hv * 8;
            float fz[8], qq[8], vv[8], qt[8], kt[8], qp[8]; unpack8(hv ? fw1 : fw0, fz); unpack8(hv ? qw1 : qw0, qq); unpack8(hv ? vw1 : vw0, vv);
            float glv = 0.f, grv = 0.f;
#pragma unroll
            for (int i = 0; i < 8; i += 2) {
                const f32x2 lbv = *(const LAS f32x2*)(LBS + dd + i);
                const f32x2 e2 = (f32x2){fz[i], fz[i + 1]} * 1.44269504f;
                f32x2 dn; dn.x = 1.0f + __builtin_amdgcn_exp2f(e2.x); dn.y = 1.0f + __builtin_amdgcn_exp2f(e2.y);
                f32x2 rc; rc.x = __builtin_amdgcn_rcpf(dn.x); rc.y = __builtin_amdgcn_rcpf(dn.y);
                const f32x2 kk = lbv * rc;
                f32x2 om = 1.0f - kk; om.x = fmaxf(om.x, 1e-20f); om.y = fmaxf(om.y, 1e-20f);
                f32x2 g2; g2.x = wave_scan_incl(__builtin_amdgcn_logf(om.x)); g2.y = wave_scan_incl(__builtin_amdgcn_logf(om.y));
                f32x2 gr, gl2; gr.x = __int_as_float(__builtin_amdgcn_readlane(__float_as_int(g2.x), 31)); gr.y = __int_as_float(__builtin_amdgcn_readlane(__float_as_int(g2.y), 31));
                gl2.x = __int_as_float(__builtin_amdgcn_readlane(__float_as_int(g2.x), 63)); gl2.y = __int_as_float(__builtin_amdgcn_readlane(__float_as_int(g2.y), 63));
                f32x2 a1 = g2 - gr, a2 = gr - g2; a1.x = fminf(a1.x, 115.f); a1.y = fminf(a1.y, 115.f); a2.x = fminf(a2.x, 115.f); a2.y = fminf(a2.y, 115.f);
                f32x2 E0, E1, E2; E0.x = __builtin_amdgcn_exp2f(g2.x); E0.y = __builtin_amdgcn_exp2f(g2.y); E1.x = __builtin_amdgcn_exp2f(a1.x); E1.y = __builtin_amdgcn_exp2f(a1.y); E2.x = __builtin_amdgcn_exp2f(a2.x); E2.y = __builtin_amdgcn_exp2f(a2.y);
                const f32x2 qv = {qq[i], qq[i + 1]}; const f32x2 qpv = qv * E0, qtv = qv * E1, ktv = kk * E2;
                qp[i] = qpv.x; qp[i + 1] = qpv.y; qt[i] = qtv.x; qt[i + 1] = qtv.y; kt[i] = ktv.x; kt[i + 1] = ktv.y;
                glv = (lane == i) ? gl2.x : glv; grv = (lane == i) ? gr.x : grv; glv = (lane == i + 1) ? gl2.y : glv; grv = (lane == i + 1) ? gr.y : grv;
                KTT[(dd + i) * 72 + tsw] = f2bf(kt[i]); VT[(dd + i) * 72 + tsw] = f2bf(vv[i]); KTT[(dd + i + 1) * 72 + tsw] = f2bf(kt[i + 1]); VT[(dd + i + 1) * 72 + tsw] = f2bf(vv[i + 1]); }
            if (lane < 8) { DL[dd + lane] = __builtin_amdgcn_exp2f(glv); EL[dd + lane] = __builtin_amdgcn_exp2f(glv - grv); GLS[dd + lane] += glv * 0.69314718f; }
            if (pass == 2) { *(LAS u32x4*)(QT + lane * 136 + dd) = pack8(qt); *(LAS u32x4*)(KT + lane * 136 + dd) = pack8(kt); *(LAS u32x4*)(QP + lane * 136 + dd) = pack8(qp); } }
        if (pass == 2) {
#pragma unroll
            for (int kb = 0; kb < 8; ++kb)
#pragma unroll
                for (int jj = 0; jj < 4; ++jj) SB[(wave * 16 + q * 4 + jj) * 136 + kb * 16 + r] = f2bf(St[kb][jj]); }
        __syncthreads();
        u32x4 gdw0 = {0u, 0u, 0u, 0u}, gdw1 = {0u, 0u, 0u, 0u};
        if (pass == 2) { const bf16_t* zg = Z + (size_t)h * ZB + row * 128 + d0 + 16 * ZB; gdw0 = *(const u32x4*)zg; gdw1 = *(const u32x4*)(zg + 8); }
        f32x4 oacc[4];
        const int ib = wave >> 1, vb0 = (wave & 1) * 4;
        if (pass == 2) {
#pragma unroll
            for (int tt = 0; tt < 2; ++tt) { const int tile = wave * 2 + tt, ia = tile >> 2, jb = tile & 3; f32x4 cc = {0.f, 0.f, 0.f, 0.f};
                if (jb <= ia) {
#pragma unroll
                    for (int ks = 0; ks < 4; ++ks) cc = MFMA16(*(const LAS bf16x8*)(QT + (ia * 16 + r) * 136 + ks * 32 + q * 8), *(const LAS bf16x8*)(KT + (jb * 16 + r) * 136 + ks * 32 + q * 8), cc); }
#pragma unroll
                for (int jj = 0; jj < 4; ++jj) { const int i = ia * 16 + q * 4 + jj, j = jb * 16 + r; AM[i * 72 + j] = f2bf((jb <= ia && j <= i) ? cc[jj] : 0.f); } }
            bf16x8 qa[4];
#pragma unroll
            for (int ks = 0; ks < 4; ++ks) qa[ks] = *(const LAS bf16x8*)(QP + (ib * 16 + r) * 136 + ks * 32 + q * 8);
#pragma unroll
            for (int vi = 0; vi < 4; ++vi) { f32x4 cc = {0.f, 0.f, 0.f, 0.f};
#pragma unroll
                for (int ks = 0; ks < 4; ++ks) cc = MFMA16(qa[ks], *(const LAS bf16x8*)(SB + ((vb0 + vi) * 16 + r) * 136 + ks * 32 + q * 8), cc);
                oacc[vi] = cc; }
            __syncthreads();
            const bf16x8 am0 = *(const LAS bf16x8*)(AM + (ib * 16 + r) * 72 + q * 8), am1 = *(const LAS bf16x8*)(AM + (ib * 16 + r) * 72 + 32 + q * 8);
#pragma unroll
            for (int vi = 0; vi < 4; ++vi) { oacc[vi] = MFMA16(am0, *(const LAS bf16x8*)(VT + ((vb0 + vi) * 16 + r) * 72 + ((q ^ (vb0 + vi)) << 3)), oacc[vi]);
                oacc[vi] = MFMA16(am1, *(const LAS bf16x8*)(VT + ((vb0 + vi) * 16 + r) * 72 + (((4 + q) ^ (vb0 + vi)) << 3)), oacc[vi]); }
        }
        { const bf16x8 va0 = *(const LAS bf16x8*)(VT + (wave * 16 + r) * 72 + ((q ^ wave) << 3)), va1 = *(const LAS bf16x8*)(VT + (wave * 16 + r) * 72 + (((4 + q) ^ wave) << 3));
#pragma unroll
          for (int kb = 0; kb < 8; ++kb) { f32x4 cc = {0.f, 0.f, 0.f, 0.f};
              cc = MFMA16(va0, *(const LAS bf16x8*)(KTT + (kb * 16 + r) * 72 + ((q ^ kb) << 3)), cc); cc = MFMA16(va1, *(const LAS bf16x8*)(KTT + (kb * 16 + r) * 72 + (((4 + q) ^ kb) << 3)), cc);
              const float dl = DL[kb * 16 + r], el = EL[kb * 16 + r]; St[kb] = St[kb] * dl + cc * el; } }
        if (pass == 2) {
#pragma unroll
            for (int vi = 0; vi < 4; ++vi)
#pragma unroll
                for (int jj = 0; jj < 4; ++jj) Os[(ib * 16 + q * 4 + jj) * 132 + (vb0 + vi) * 16 + r] = oacc[vi][jj];
            __syncthreads();
            float ov[16]; float ss = 0.f;
#pragma unroll
            for (int i = 0; i < 4; ++i) { const f32x4 v = *(const LAS f32x4*)(Os + t * 132 + d0 + 4 * i); ov[4 * i] = v[0]; ov[4 * i + 1] = v[1]; ov[4 * i + 2] = v[2]; ov[4 * i + 3] = v[3];
                ss += (v[0] * v[0] + v[1] * v[1]) + (v[2] * v[2] + v[3] * v[3]); }
            ss += __shfl_xor(ss, 1); ss += __shfl_xor(ss, 2); ss += __shfl_xor(ss, 4);
            const float rstd = __builtin_amdgcn_rsqf(ss * (1.0f / 128.0f) + 1e-6f);
            float gd0[8], gd1[8]; unpack8(gdw0, gd0); unpack8(gdw1, gd1);
            const LAS float* ng = NGS + d0;
            float y0[8], y1[8];
#pragma unroll
            for (int i = 0; i < 8; ++i) { y0[i] = ov[i] * rstd * ng[i] * (gd0[i] * sigmoidf_(gd0[i])); y1[i] = ov[8 + i] * rstd * ng[8 + i] * (gd1[i] * sigmoidf_(gd1[i])); }
            bf16_t* yp = Y + row * 1024 + 512 + h * 128 + d0;
            *(u32x4*)yp = pack8(y0); *(u32x4*)(yp + 8) = pack8(y1);
        }
        __syncthreads();
    }
    if (pass == 1) {
#pragma unroll
        for (int kb = 0; kb < 8; ++kb)
#pragma unroll
            for (int jj = 0; jj < 4; ++jj) DS[(wave * 16 + q * 4 + jj) * 128 + kb * 16 + r] = St[kb][jj];
        if (tid < 128) GLB[tid] = GLS[tid];
    }
    __syncthreads();
}
__device__ __forceinline__ void hgrn_scan(KA a) {
    const int G = gridDim.x;
    for (int item = blockIdx.x * 512 + tid_now(); item < 16 * 8192; item += G * 512) {
        const int bh = item >> 13, e2 = item & 8191, bb = bh >> 2, h = bh & 3, k2 = (e2 & 63) * 2;
        f32x2* ds = (f32x2*)((float*)(a->ws + OFF_ST) + ((size_t)(bb * 32 * 4 + h)) * 16384) + e2;
        const f32x2* gl = (const f32x2*)((const float*)(a->ws + OFF_GL) + ((size_t)(bb * 32 * 4 + h)) * 128 + k2);
        f32x2 run = {0.f, 0.f};
#pragma unroll 16
        for (int blk = 0; blk < 32; ++blk) { const f32x2 tmp = ds[(size_t)blk * 4 * 8192]; const f32x2 g = gl[(size_t)blk * 4 * 64];
            ds[(size_t)blk * 4 * 8192] = run; run.x = __expf(g.x) * run.x + tmp.x; run.y = __expf(g.y) * run.y + tmp.y; }
    }
}

__device__ __forceinline__ void phase_act(KA a, int l) {
    const bf16_t* U = (const bf16_t*)(a->ws + OFF_U); bf16_t* Gt = (bf16_t*)(a->ws + OFF_G);
    const float* cw = a->in[22] + (size_t)l * 3 * FFD; const float* cb = a->in[23] + (size_t)l * FFD;
    const int G = gridDim.x;
    for (int item = blockIdx.x * 512 + tid_now(); item < T_TOK * 352; item += G * 512) {
        const int tok = item / 352, c8 = (item - tok * 352) * 8, pos = tok & (SEQL - 1);
        float acc[8]; { const f32x4 b0 = *(const f32x4*)(cb + c8), b1 = *(const f32x4*)(cb + c8 + 4); acc[0] = b0[0]; acc[1] = b0[1]; acc[2] = b0[2]; acc[3] = b0[3]; acc[4] = b1[0]; acc[5] = b1[1]; acc[6] = b1[2]; acc[7] = b1[3]; }
#pragma unroll
        for (int j = 0; j < 3; ++j) { const int d = 2 - j;
            if (pos >= d) { float u[8]; unpack8(*(const u32x4*)(U + (size_t)(tok - d) * FFD + c8), u);
                const f32x4 w0 = *(const f32x4*)(cw + j * FFD + c8), w1 = *(const f32x4*)(cw + j * FFD + c8 + 4);
                acc[0] += w0[0] * u[0]; acc[1] += w0[1] * u[1]; acc[2] += w0[2] * u[2]; acc[3] += w0[3] * u[3]; acc[4] += w1[0] * u[4]; acc[5] += w1[1] * u[5]; acc[6] += w1[2] * u[6]; acc[7] += w1[3] * u[7]; } }
        float gt[8]; unpack8(*(const u32x4*)(Gt + (size_t)tok * FFD + c8), gt);
#pragma unroll
        for (int i = 0; i < 8; ++i) acc[i] = gelu_tanh(acc[i]) * gt[i];
        *(u32x4*)(Gt + (size_t)tok * FFD + c8) = pack8(acc);
    }
}
__device__ __forceinline__ void phase_final(KA a) {
    const float* ssq = (const float*)(a->ws + OFF_SSQ); const float* gf = a->in[3]; float* out = a->out; const bf16_t* X = (const bf16_t*)(a->ws + OFF_XG);
    const int G = gridDim.x, tid = tid_now(), lane = tid & 63, wave = tid >> 6;
    f32x4 g[4];
#pragma unroll
    for (int i = 0; i < 4; ++i) g[i] = *(const f32x4*)(gf + (i >> 1) * 512 + lane * 8 + (i & 1) * 4);
    for (int row0 = blockIdx.x * 8 + wave; row0 < T_TOK; row0 += G * 8 * 4) {
        u32x4 xw[4][2]; f32x4 sq[4];
#pragma unroll
        for (int rr = 0; rr < 4; ++rr) { const int row = (row0 + rr * G * 8 < T_TOK) ? row0 + rr * G * 8 : T_TOK - 1;
            xw[rr][0] = *(const u32x4*)(X + (size_t)row * 1024 + lane * 8); xw[rr][1] = *(const u32x4*)(X + (size_t)row * 1024 + 512 + lane * 8); sq[rr] = *(const f32x4*)(ssq + (size_t)row * 4); }
#pragma unroll
        for (int rr = 0; rr < 4; ++rr) { const int row = row0 + rr * G * 8; if (row >= T_TOK) continue;
            const float rs = rsqrtf(((sq[rr][0] + sq[rr][1]) + (sq[rr][2] + sq[rr][3])) * (1.0f / 1024.0f) + 1e-6f);
#pragma unroll
            for (int hh = 0; hh < 2; ++hh) { float xv[8]; unpack8(xw[rr][hh], xv); float* op = out + (size_t)row * 1024 + hh * 512 + lane * 8;
                *(f32x4*)op = (f32x4){xv[0], xv[1], xv[2], xv[3]} * rs * g[2 * hh]; *(f32x4*)(op + 4) = (f32x4){xv[4], xv[5], xv[6], xv[7]} * rs * g[2 * hh + 1]; } }
    }
}
__device__ __forceinline__ void act_fixup(KA a, int l, int pm) {
    const float* EU = (const float*)(a->ws + OFF_EU); const float* EG = (const float*)(a->ws + OFF_EG); bf16_t* ACT = (bf16_t*)(a->ws + OFF_G);
    const float* cw = a->in[22] + (size_t)l * 3 * FFD; const float* cb = a->in[23] + (size_t)l * FFD;
    const bool first = (pm & 31) == 0;
    const int tid0 = tid_now();
#pragma unroll
    for (int k = 0; k < 11; ++k) { const int e = tid0 + 512 * k; const int rr = e >= FFD ? 1 : 0, col = e - rr * FFD;
        const float u0 = EU[((size_t)(pm * 4 + rr)) * FFD + col];
        const float pl = first ? 0.f : EU[((size_t)((pm - 1) * 4 + 3)) * FFD + col];
        float u1, u2;
        if (rr == 0) { u1 = pl; u2 = first ? 0.f : EU[((size_t)((pm - 1) * 4 + 2)) * FFD + col]; }
        else { u1 = EU[((size_t)(pm * 4)) * FFD + col]; u2 = pl; }
        const float g = EG[((size_t)(pm * 2 + rr)) * FFD + col];
        const float v = gelu_tanh(cb[col] + cw[2 * FFD + col] * u0 + cw[FFD + col] * u1 + cw[col] * u2) * g;
        ACT[((size_t)(pm * 256 + rr)) * FFD + col] = f2bf(v); }
}
#ifndef STAG_N
#define STAG_N 3
#endif
#define STAGGER() do { if ((bx >> 3) & 1) { for (int s_ = 0; s_ < STAG_N; ++s_) __builtin_amdgcn_s_sleep(127); } } while (0)
#ifndef REP_G1_SKIP
#define REP_G1_SKIP 0
#endif
#ifndef REP_BAR
#define REP_BAR 1
#endif
#ifndef REP_LRU1
#define REP_LRU1 1
#endif
#ifndef REP_SCONV
#define REP_SCONV 1
#endif
#ifndef REP_LRU2
#define REP_LRU2 1
#endif
#ifndef REP_HG1
#define REP_HG1 1
#endif
#ifndef REP_POOL
#define REP_POOL 1
#endif
#ifndef REP_HG2
#define REP_HG2 1
#endif
#ifndef G1_ALIGN
#define G1_ALIGN false
#endif
#ifndef REP_SYNC
#define REP_SYNC 1
#endif
#ifndef REP_G1
#define REP_G1 1
#endif
#ifndef REP_EVEN
#define REP_EVEN 1
#endif
#ifndef REP_ODD
#define REP_ODD 1
#endif
#ifndef REP_PRO
#define REP_PRO 1
#endif
#ifndef REP_G3
#define REP_G3 1
#endif
__global__ void __launch_bounds__(512, 2) mega_fwd(Args a_byval) {
    extern __shared__ __attribute__((aligned(16))) unsigned char lds_raw[];
    LAS unsigned char* lds = (LAS unsigned char*)lds_raw;
    cg::grid_group grid = cg::this_grid();
    KA a0 = (KA)__builtin_amdgcn_kernarg_segment_ptr();
    volatile LAS unsigned* xst = (volatile LAS unsigned*)(lds + LDS_BYTES - 256);
    if (threadIdx.x < 4) xst[threadIdx.x] = 0u;
    __syncthreads();
    if (blockIdx.x == 0) { unsigned* bw = (unsigned*)(a0->ws + OFF_BAR); for (int i = threadIdx.x; i < XCD_BAR_WORDS; i += 512) bw[i] = 0u; }
    XcdBarrier xbar; xbar.bar = (unsigned*)(a0->ws + OFF_BAR); xbar.x = 0u; xbar.st = xst;
    const int G = gridDim.x, bx = blockIdx.x;
    const int ph_lo = a0->ph_lo, ph_hi = a0->ph_hi;
    for (int ph = ph_lo; ph < ph_hi; ++ph) {
        bool did = true;
        KA a = a0; asm volatile("" : "+s"(a));
        float* ssq = (float*)(a->ws + OFF_SSQ);
        bf16_t* XG = (bf16_t*)(a->ws + OFF_XG); bf16_t* Ub = (bf16_t*)(a->ws + OFF_U); bf16_t* Gb = (bf16_t*)(a->ws + OFF_G);
        if (ph == 0) { for (int rep = 0; rep < REP_PRO; ++rep) phase_prologue(a, lds); }
        else if (ph == 33) phase_final(a);
        else {
            const int l = (ph - 1) >> 3, s = (ph - 1) & 7, odd = l & 1, hl = l >> 1;
            const bf16_t* Wl = (const bf16_t*)(a->ws + OFF_W) + (size_t)l * W_LAYER;
            if (s == 0) {
                pg8::Gemm g{XG, Wl + W_IN, T_TOK, ZW, DM}; pg8::StaticOrder S; S.init(T_TOK, ZW, G, bx);
                pg8::EpiScale E{Ub, ZW, ssq, 0};
                for (int rep = 0; rep < REP_G1; ++rep) { E.skip = (rep > 0) ? REP_G1_SKIP : 0; pg8::gemm_phase<pg8::EpiScale, pg8::StaticOrder, G1_ALIGN, true>(lds, g, S, E); }
            } else if (s == 1) { for (int rep = 0; rep < (odd ? REP_ODD : REP_EVEN); ++rep) {
                if (!odd) { for (int r1 = 0; r1 < REP_LRU1; ++r1) { int ph_ = -1; u32x4 pf[3]; lru_load_xh(a, bx & 2047, tid_now(), pf); for (int u = bx; u < 2048; u += G) { lru_unit(a, lds, hl, u, 1, (u & 7) != ph_, pf, (u + G < 2048) ? u + G : -1); ph_ = u & 7; } }
                            for (int r2 = 0; r2 < REP_SCONV; ++r2) for (int u = bx; u < 1024; u += G) sconv_unit(a, hl, u); }
                else      { for (int r1 = 0; r1 < REP_HG1; ++r1) { u32x4 nx[6]; hgrn_load_first(a, bx & 511, tid_now(), 1, nx); for (int u = bx; u < 512; u += G) hgrn_unit(a, lds, hl, u, 1, nx, (u + G < 512) ? u + G : -1); }
                            for (int r2 = 0; r2 < REP_POOL; ++r2) { int pg_ = -1; u32x4 pq[5]; pool_load_uh(a, bx & 1023, tid_now(), pq); for (int u = bx; u < 1024; u += G) { pool_unit(a, lds, hl, u, (u & 3) != pg_, pq, (u + G < 1024) ? u + G : -1); pg_ = u & 3; } } } }
            } else if (s == 2) {
                if (odd) hgrn_scan(a); else did = false;
            } else if (s == 3) { for (int rep = 0; rep < (odd ? REP_ODD : REP_EVEN); ++rep) {
                if (!odd) { for (int r1 = 0; r1 < REP_LRU2; ++r1) { int ph_ = -1; u32x4 pf[3]; lru_load_xh(a, bx & 2047, tid_now(), pf); for (int u = bx; u < 2048; u += G) { lru_unit(a, lds, hl, u, 2, (u & 7) != ph_, pf, (u + G < 2048) ? u + G : -1); ph_ = u & 7; } } }
                else      { for (int r1 = 0; r1 < REP_HG2; ++r1) { u32x4 nx[6]; hgrn_load_first(a, bx & 511, tid_now(), 2, nx); for (int u = bx; u < 512; u += G) hgrn_unit(a, lds, hl, u, 2, nx, (u + G < 512) ? u + G : -1); } } }
            } else if (s == 4 || s == 7) {
                const bool dn = (s == 7);
                pg8::Gemm g{dn ? Gb : Gb  , Wl + (dn ? W_DN : W_OUT), T_TOK, DM, dn ? FFD : DM}; pg8::StaticOrder S; S.init(T_TOK, DM, G, bx);
                if (dn) { pg8::Unit fu; for (int i = 0; S.next(i, fu); ++i) act_fixup(a, l, fu.pm);
                          asm volatile("s_waitcnt vmcnt(0)" ::: "memory"); __syncthreads(); }
                pg8::EpiRes E{XG, ssq, (LAS float*)(lds + 131072)};
                pg8::gemm_phase<pg8::EpiRes, pg8::StaticOrder, true, true>(lds, g, S, E);
            } else if (s == 5) {
                pg8::Gemm g{XG, Wl + W_UG, T_TOK, 2 * FFD, DM}; pg8::StaticOrder S; S.init(T_TOK, 2 * FFD, G, bx);
                pg8::EpiAct E{Gb, ssq, a->in[22] + (size_t)l * 3 * FFD, a->in[23] + (size_t)l * FFD, (float*)(a->ws + OFF_EU), (float*)(a->ws + OFF_EG), (LAS float*)(lds + 131072)};
                for (int rep = 0; rep < REP_G3; ++rep) pg8::gemm_phase<pg8::EpiAct, pg8::StaticOrder, true, true>(lds, g, S, E);
            } else { did = false; }
        }
        if (did && ph + 1 < ph_hi) { if (ph == 0) { grid.sync(); xbar = xcd_barrier_post((unsigned*)(a0->ws + OFF_BAR), xst); } else { for (int rb = 0; rb < REP_BAR; ++rb) xcd_barrier(xbar); } }
    }
}

#ifndef MK_MULTI
#define MK_MULTI 0
#endif
extern "C" void kernel_launch(void* const* d_in, const int* in_sizes, int n_in, void* d_out, int out_size, void* d_ws, size_t ws_size, hipStream_t stream) {
    static int grid = 0;
    if (grid == 0) {
        if (n_in != 25 || ws_size < WS_END) { fprintf(stderr, "kernel_launch: unexpected n_in %d or ws_size %zu (< %zu)\n", n_in, ws_size, (size_t)WS_END); grid = -1; return; }
        int dev = 0, cus = 0, per_cu = 0;
        if (hipGetDevice(&dev) != hipSuccess || hipDeviceGetAttribute(&cus, hipDeviceAttributeMultiprocessorCount, dev) != hipSuccess) { grid = -1; return; }
        if (hipFuncSetAttribute((const void*)mega_fwd, hipFuncAttributeMaxDynamicSharedMemorySize, LDS_BYTES) != hipSuccess) { fprintf(stderr, "kernel_launch: hipFuncSetAttribute failed\n"); grid = -1; return; }
        if (hipOccupancyMaxActiveBlocksPerMultiprocessor(&per_cu, (const void*)mega_fwd, 512, LDS_BYTES) != hipSuccess || per_cu < 1) fprintf(stderr, "kernel_launch: occupancy query says %d\n", per_cu);
        (void)hipGetLastError();
        grid = cus;
    }
    if (grid < 0) return;
    Args a{};
    for (int i = 0; i < 25; ++i) a.in[i] = (const float*)d_in[i];
    a.out = (float*)d_out; a.ws = (unsigned char*)d_ws;
#if MK_MULTI
    for (int ph = 0; ph < 34; ++ph) { a.ph_lo = ph; a.ph_hi = ph + 1; void* args[] = {&a};
        if (ph >= 1 && ph < 33 && ((ph - 1) & 7) == 2 && (((ph - 1) >> 3) & 1) == 0) continue;
        hipError_t e = hipLaunchCooperativeKernel((const void*)mega_fwd, dim3(grid), dim3(512), args, LDS_BYTES, stream);
        if (e != hipSuccess) { fprintf(stderr, "launch %d failed: %s\n", ph, hipGetErrorString(e)); break; } }
#else
    a.ph_lo = 0; a.ph_hi = 34; void* args[] = {&a};
    hipError_t e = hipLaunchCooperativeKernel((const void*)mega_fwd, dim3(grid), dim3(512), args, LDS_BYTES, stream);
    if (e != hipSuccess) fprintf(stderr, "cooperative launch failed: %s (grid %d)\n", hipGetErrorString(e), grid);
#endif
}
```

```cpp
#include <hip/hip_runtime.h>
#include <hip/hip_cooperative_groups.h>
#include <cstdio>
#include <cstdint>
namespace cg = cooperative_groups;
__device__ __forceinline__ int tid_now() { int t = threadIdx.x; asm volatile("" : "+v"(t)); return t; }
#ifndef PG8_WGM
#define PG8_WGM 8
#endif
#ifndef PG8_NOPRIO
#define PG8_NOPRIO 0
#endif
#if PG8_NOPRIO
#define PG8_PRIO(x) do {} while (0)
#else
#define PG8_PRIO(x) __builtin_amdgcn_s_setprio(x)
#endif
namespace pg8 {
#define PG8_LAS __attribute__((address_space(3)))
typedef unsigned short bf16_t;
typedef short bf16x8 __attribute__((ext_vector_type(8)));
typedef float f32x4 __attribute__((ext_vector_type(4)));
typedef unsigned u32x4 __attribute__((ext_vector_type(4)));
typedef unsigned u32x2 __attribute__((ext_vector_type(2)));
constexpr int BM = 256, BK = 64, HALF = 128, HTB = HALF * BK * 2  , STAGE_BYTES = 8 * HTB, NXCD = 8, WGM = PG8_WGM;

__host__ __device__ __forceinline__ int lds_byte(int r, int c) { const int st = (r >> 4) * 2 + (c >> 5), rr = r & 15, cc = c & 31, ob = rr * 64 + cc * 2; return st * 1024 + (ob ^ (((ob >> 9) & 1) << 5)); }
__host__ __device__ __forceinline__ void stage_rc(int b, int& R, int& C) { const int st = b / 1024, sb = b % 1024, swz = sb ^ (((sb >> 9) & 1) << 5); R = (st >> 1) * 16 + swz / 64; C = (st & 1) * 32 + (swz % 64) / 2; }
__host__ __device__ __forceinline__ int perm32(int rho) { const int n = rho >> 4, i = rho & 15; return 8 * (i >> 2) + 4 * n + (i & 3); }

struct Unit { int pm, pn; };
struct Gemm { const bf16_t* A; const bf16_t* Bt; int M, N, K; };

struct StaticOrder {
    int nM, nN, nwg, G, c;
    __host__ __device__ void init(int M, int N, int G_, int c_) { nM = M / BM; nN = N / BM; nwg = nM * nN; G = G_; c = c_; }
    __host__ __device__ bool next(int i, Unit& u) const {
        const long L = (long)i * G + c; if (L >= nwg) return false;
        int wgid = (int)L; { const int q = nwg / NXCD, r = nwg % NXCD, xcd = wgid % NXCD, off = wgid / NXCD; wgid = (xcd < r ? xcd * (q + 1) : r * (q + 1) + (xcd - r) * q) + off; }
        const int nig = WGM * nN, gid = wgid / nig, fm = gid * WGM, gsz = (nM - fm) < WGM ? (nM - fm) : WGM;
        u.pm = fm + ((wgid % nig) % gsz); u.pn = (wgid % nig) / gsz; return true;
    }
    __device__ __forceinline__ void a_ready(const Unit&) const {}
    __device__ __forceinline__ void done(const Unit&) const {}
};

__device__ __forceinline__ unsigned cvt_pk_bf16(float lo, float hi) { unsigned r; asm volatile("v_cvt_pk_bf16_f32 %0, %1, %2" : "=v"(r) : "v"(lo), "v"(hi)); return r; }

__device__ __forceinline__ float row_rstd(const float* ssq4, int r) {
    const f32x4 a = *(const f32x4*)(ssq4 + (size_t)r * 4);
    return __builtin_amdgcn_rsqf(((a[0] + a[1]) + (a[2] + a[3])) * (1.0f / 1024.0f) + 1e-6f); }
#ifndef Z_NT
#define Z_NT 0
#endif
#if Z_NT
#define ZSTORE(v, p) __builtin_nontemporal_store((v), (p))
#else
#define ZSTORE(v, p) (*(p) = (v))
#endif
struct EpiScale {
    static constexpr bool PERM = true, AFTER_DRAIN = false;
    bf16_t* O; int ldc; const float* ssq; int skip;
    __device__ __forceinline__ void operator()(const f32x4 (&acc)[2][2][4][2], const Unit& u, int wr_, int wc_, int fr_, int fq_) const {
        const int t_ = tid_now(), fr = t_ & 15, fq = (t_ >> 4) & 3, wc = (t_ >> 6) & 3, wr = t_ >> 8;
        if (skip) return;
        const int row0 = u.pm * BM + wr * 64 + fr, col0 = u.pn * BM + wc * 32 + 8 * fq;
#pragma unroll
        for (int ai = 0; ai < 2; ++ai)
#pragma unroll
            for (int m = 0; m < 4; ++m) { const int r = row0 + ai * HALF + m * 16; const float rs = row_rstd(ssq, r);
#pragma unroll
                for (int bj = 0; bj < 2; ++bj) { const f32x4 v0 = acc[ai][bj][m][0] * rs, v1 = acc[ai][bj][m][1] * rs;
                    u32x4 w; w.x = cvt_pk_bf16(v0[0], v0[1]); w.y = cvt_pk_bf16(v0[2], v0[3]); w.z = cvt_pk_bf16(v1[0], v1[1]); w.w = cvt_pk_bf16(v1[2], v1[3]);
                    ZSTORE(w, (u32x4*)(O + ((size_t)(u.pn * 2 + bj) * 32768 + r) * 128 + wc * 32 + 8 * fq)); } }
    }
};
struct EpiUG {
    static constexpr bool PERM = true, AFTER_DRAIN = false;
    bf16_t* U; bf16_t* G; const float* ssq;
    __device__ __forceinline__ void operator()(const f32x4 (&acc)[2][2][4][2], const Unit& u, int wr_, int wc_, int fr_, int fq_) const {
        const int t_ = tid_now(), fr = t_ & 15, fq = (t_ >> 4) & 3, wc = (t_ >> 6) & 3, wr = t_ >> 8;
        const int row0 = u.pm * BM + wr * 64 + fr, col0 = u.pn * HALF + wc * 32 + 8 * fq;
#pragma unroll
        for (int ai = 0; ai < 2; ++ai)
#pragma unroll
            for (int m = 0; m < 4; ++m) { const int r = row0 + ai * HALF + m * 16; const float rs = row_rstd(ssq, r);
#pragma unroll
                for (int bj = 0; bj < 2; ++bj) { const f32x4 v0 = acc[ai][bj][m][0] * rs, v1 = acc[ai][bj][m][1] * rs;
                    u32x4 w; w.x = cvt_pk_bf16(v0[0], v0[1]); w.y = cvt_pk_bf16(v0[2], v0[3]); w.z = cvt_pk_bf16(v1[0], v1[1]); w.w = cvt_pk_bf16(v1[2], v1[3]);
                    *(u32x4*)((bj ? G : U) + (size_t)r * 2816 + col0) = w; } }
    }
};
struct EpiRes {
    static constexpr bool PERM = true, AFTER_DRAIN = false;
    bf16_t* X; float* ssq_next; PG8_LAS float* PS;
    __device__ __forceinline__ void operator()(const f32x4 (&acc)[2][2][4][2], const Unit& u, int wr_, int wc_, int fr_, int fq_) const {
        const int t_ = tid_now(), fr = t_ & 15, fq = (t_ >> 4) & 3, wc = (t_ >> 6) & 3, wr = t_ >> 8;
        const int row0 = u.pm * BM + wr * 64 + fr, col0 = u.pn * BM + wc * 32 + 8 * fq;
#pragma unroll
        for (int ai = 0; ai < 2; ++ai)
#pragma unroll
            for (int m = 0; m < 4; ++m) { const int r = row0 + ai * HALF + m * 16; bf16_t* xp = X + (size_t)r * 1024 + col0; float s = 0.f;
#pragma unroll
                for (int bj = 0; bj < 2; ++bj) {
                    const u32x4 xw = *(const u32x4*)(xp + bj * HALF); const f32x4 a0 = acc[ai][bj][m][0], a1 = acc[ai][bj][m][1];
                    u32x4 w; w.x = cvt_pk_bf16(__uint_as_float(xw.x << 16) + a0[0], __uint_as_float(xw.x & 0xffff0000u) + a0[1]); w.y = cvt_pk_bf16(__uint_as_float(xw.y << 16) + a0[2], __uint_as_float(xw.y & 0xffff0000u) + a0[3]);
                    w.z = cvt_pk_bf16(__uint_as_float(xw.z << 16) + a1[0], __uint_as_float(xw.z & 0xffff0000u) + a1[1]); w.w = cvt_pk_bf16(__uint_as_float(xw.w << 16) + a1[2], __uint_as_float(xw.w & 0xffff0000u) + a1[3]);
                    *(u32x4*)(xp + bj * HALF) = w;
                    const float y0 = __uint_as_float(w.x << 16), y1 = __uint_as_float(w.x & 0xffff0000u), y2 = __uint_as_float(w.y << 16), y3 = __uint_as_float(w.y & 0xffff0000u);
                    const float y4 = __uint_as_float(w.z << 16), y5 = __uint_as_float(w.z & 0xffff0000u), y6 = __uint_as_float(w.w << 16), y7 = __uint_as_float(w.w & 0xffff0000u);
                    s += ((y0 * y0 + y1 * y1) + (y2 * y2 + y3 * y3)) + ((y4 * y4 + y5 * y5) + (y6 * y6 + y7 * y7)); }
                s += __shfl_xor(s, 16); s += __shfl_xor(s, 32);
                if (fq == 0) PS[wc * 256 + ai * HALF + wr * 64 + m * 16 + fr] = s;
                asm volatile("" ::: "memory"); }
        asm volatile("s_waitcnt lgkmcnt(0)" ::: "memory"); __builtin_amdgcn_s_barrier(); asm volatile("" ::: "memory");
        const int tid = (wr * 4 + wc) * 64 + fq * 16 + fr;
        if (tid < 256) ssq_next[(size_t)(u.pm * BM + tid) * 4 + u.pn] = (PS[tid] + PS[256 + tid]) + (PS[512 + tid] + PS[768 + tid]);
    }
};
typedef float f32x2 __attribute__((ext_vector_type(2)));
__device__ __forceinline__ float gelu_tanh_(float x) { const float u = 1.5957691216057308f * (x + 0.044715f * x * x * x); return x * __builtin_amdgcn_rcpf(1.0f + __expf(-u)); }
struct EpiAct {
    static constexpr bool PERM = true, AFTER_DRAIN = false;
    bf16_t* ACT; const float* ssq; const float* cw; const float* cb; float* EU; float* EG; PG8_LAS float* HX;
    __device__ __forceinline__ void operator()(f32x4 (&acc)[2][2][4][2], const Unit& u, int wr_, int wc_, int fr_, int fq_) const {
        const int t_ = tid_now(), fr = t_ & 15, fq = (t_ >> 4) & 3, wc = (t_ >> 6) & 3, wr = t_ >> 8;
        const int lane = fq * 16 + fr;
        const int row0 = u.pm * BM + wr * 64 + fr, col0 = u.pn * HALF + wc * 32 + 8 * fq;
        f32x4 w0[2], w1[2], w2[2], bb[2];
#pragma unroll
        for (int n = 0; n < 2; ++n) { w0[n] = *(const f32x4*)(cw + col0 + 4 * n); w1[n] = *(const f32x4*)(cw + 2816 + col0 + 4 * n); w2[n] = *(const f32x4*)(cw + 2 * 2816 + col0 + 4 * n); bb[n] = *(const f32x4*)(cb + col0 + 4 * n); }
#pragma unroll
        for (int ai = 0; ai < 2; ++ai)
#pragma unroll
            for (int m = 0; m < 4; ++m) { const float rs = row_rstd(ssq, row0 + ai * HALF + m * 16);
#pragma unroll
                for (int bj = 0; bj < 2; ++bj) { acc[ai][bj][m][0] *= rs; acc[ai][bj][m][1] *= rs; } }
        if (fr >= 14) {
#pragma unroll
            for (int ai = 0; ai < 2; ++ai) { PG8_LAS float* hp = HX + ((((ai * 2 + wr) * 4 + wc) * 4 + fq) * 2 + (fr - 14)) * 8;
                *(PG8_LAS f32x4*)hp = acc[ai][0][3][0]; *(PG8_LAS f32x4*)(hp + 4) = acc[ai][0][3][1]; } }
        if (wr == 0 && fr < 2) { float* p = EU + ((size_t)(u.pm * 4 + fr)) * 2816 + col0; *(f32x4*)p = acc[0][0][0][0]; *(f32x4*)(p + 4) = acc[0][0][0][1];
            float* g = EG + ((size_t)(u.pm * 2 + fr)) * 2816 + col0; *(f32x4*)g = acc[0][1][0][0]; *(f32x4*)(g + 4) = acc[0][1][0][1]; }
        if (wr == 1 && fr >= 14) { float* p = EU + ((size_t)(u.pm * 4 + 2 + (fr - 14))) * 2816 + col0; *(f32x4*)p = acc[1][0][3][0]; *(f32x4*)(p + 4) = acc[1][0][3][1]; }
        asm volatile("s_waitcnt lgkmcnt(0)" ::: "memory"); __builtin_amdgcn_s_barrier(); asm volatile("" ::: "memory");
#pragma unroll
        for (int ai = 0; ai < 2; ++ai) {
            f32x4 pR1[2], pR2[2];
            { const int sai = wr ? ai : ai - 1, swr = wr ? 0 : 1;
              if (sai >= 0) { const PG8_LAS float* hp = HX + ((((sai * 2 + swr) * 4 + wc) * 4 + fq) * 2) * 8;
#pragma unroll
                  for (int n = 0; n < 2; ++n) { const f32x4 h14 = *(const PG8_LAS f32x4*)(hp + 4 * n), h15 = *(const PG8_LAS f32x4*)(hp + 8 + 4 * n); pR1[n] = h15; pR2[n] = (fr == 0) ? h14 : h15; } }
              else { pR1[0] = pR1[1] = pR2[0] = pR2[1] = (f32x4){0.f, 0.f, 0.f, 0.f}; } }
#pragma unroll
            for (int m = 0; m < 4; ++m) { u32x4 w;
#pragma unroll
                for (int n = 0; n < 2; ++n) { const f32x4 up = acc[ai][0][m][n], gt = acc[ai][1][m][n]; f32x4 av;
                    { f32x4 u1, u2;
#pragma unroll
                      for (int j = 0; j < 4; ++j) {
                          u1[j] = __int_as_float(__builtin_amdgcn_update_dpp(__float_as_int(pR1[n][j]), __float_as_int(up[j]), 0x111, 0xf, 0xf, false));
                          u2[j] = __int_as_float(__builtin_amdgcn_update_dpp(__float_as_int(pR2[n][j]), __float_as_int(up[j]), 0x112, 0xf, 0xf, false));
                          if (m < 3) { pR1[n][j] = __int_as_float(__builtin_amdgcn_update_dpp(0, __float_as_int(up[j]), 0x121, 0xf, 0xf, true));
                                       pR2[n][j] = __int_as_float(__builtin_amdgcn_update_dpp(0, __float_as_int(up[j]), 0x122, 0xf, 0xf, true)); } }
#pragma unroll
                      for (int hh = 0; hh < 2; ++hh) {
                          const f32x2 upv = {up[2 * hh], up[2 * hh + 1]}, u1v = {u1[2 * hh], u1[2 * hh + 1]}, u2v = {u2[2 * hh], u2[2 * hh + 1]}, gtv = {gt[2 * hh], gt[2 * hh + 1]};
                          const f32x2 bbv = {bb[n][2 * hh], bb[n][2 * hh + 1]}, w0v = {w0[n][2 * hh], w0[n][2 * hh + 1]}, w1v = {w1[n][2 * hh], w1[n][2 * hh + 1]}, w2v = {w2[n][2 * hh], w2[n][2 * hh + 1]};
                          const f32x2 c = bbv + w2v * upv + w1v * u1v + w0v * u2v;
                          const f32x2 arg = c * ((c * c) * (-0.10294324f) + (-2.3022082f));
                          f32x2 ex; ex.x = __builtin_amdgcn_exp2f(arg.x); ex.y = __builtin_amdgcn_exp2f(arg.y);
                          const f32x2 d = ex + 1.0f; f32x2 rc; rc.x = __builtin_amdgcn_rcpf(d.x); rc.y = __builtin_amdgcn_rcpf(d.y);
                          const f32x2 a2 = (c * rc) * gtv; av[2 * hh] = a2.x; av[2 * hh + 1] = a2.y; } }
                    if (n == 0) { w.x = cvt_pk_bf16(av[0], av[1]); w.y = cvt_pk_bf16(av[2], av[3]); } else { w.z = cvt_pk_bf16(av[0], av[1]); w.w = cvt_pk_bf16(av[2], av[3]); } }
                *(u32x4*)(ACT + (size_t)(row0 + ai * HALF + m * 16) * 2816 + col0) = w; }
        }
    }
};

template <class Epi, class Sched, bool ALIGN_EPI = false, bool SP2 = false>
__device__ __forceinline__ void gemm_phase(PG8_LAS unsigned char* lds, const Gemm g, const Sched& S, const Epi& E) {
    const int tid = tid_now(), wid = __builtin_amdgcn_readfirstlane(tid >> 6), lane = tid & 63, wr = wid >> 2, wc = wid & 3, fr = lane & 15, fq = lane >> 4;
    const int K = g.K, nt = K / BK;
    unsigned voffA[2], voffB[2];
#pragma unroll
    for (int i = 0; i < 2; ++i) { int R, C; stage_rc(tid * 16 + i * 8192, R, C); const int Rb = Epi::PERM ? ((R & ~31) + perm32(R & 31)) : R;
        voffA[i] = (unsigned)(R * K + C) * 2u; voffB[i] = (unsigned)(Rb * K + C) * 2u; }
    const size_t kstep = (size_t)(BK * 2);
    const size_t hstep = (size_t)HALF * K * 2;
    const size_t tstep = 2 * hstep;
    const unsigned ldsw = (unsigned)wid * 1024u;
    const int aoff = lds_byte(wr * 64 + fr, fq * 8), boff = lds_byte(wc * 32 + fr, fq * 8);
#define PG8_SA(b, h) (((b) * 2 + (h)) * HTB)
#define PG8_SB(b, h) ((4 + (b) * 2 + (h)) * HTB)
#define PG8_STAGE(bufoff, gbase, voff) do { _Pragma("unroll") for (int _i = 0; _i < 2; ++_i) \
        __builtin_amdgcn_global_load_lds((const unsigned*)((const char*)(gbase) + (voff)[_i]), (PG8_LAS unsigned*)(lds + (bufoff) + ldsw + _i * 8192), 16, 0, 0); } while (0)
#define PG8_LDA(dst, b, h) do { _Pragma("unroll") for (int m = 0; m < 4; ++m) _Pragma("unroll") for (int k = 0; k < 2; ++k) dst[m][k] = *(const PG8_LAS bf16x8*)(lds + PG8_SA(b, h) + aoff + m * 2048 + k * 1024); } while (0)
#define PG8_LDB(dst, b, h) do { _Pragma("unroll") for (int n = 0; n < 2; ++n) _Pragma("unroll") for (int k = 0; k < 2; ++k) dst[n][k] = *(const PG8_LAS bf16x8*)(lds + PG8_SB(b, h) + boff + n * 2048 + k * 1024); } while (0)
#define PG8_MMA(ai, bj, At, Bt) do { __builtin_amdgcn_s_setprio(1); _Pragma("unroll") for (int m = 0; m < 4; ++m) _Pragma("unroll") for (int n = 0; n < 2; ++n) _Pragma("unroll") for (int k = 0; k < 2; ++k) \
        acc[ai][bj][m][n] = __builtin_amdgcn_mfma_f32_16x16x32_bf16(Bt[n][k], At[m][k], acc[ai][bj][m][n], 0, 0, 0); __builtin_amdgcn_s_setprio(0); } while (0)
#define PG8_WAIT_V(n) asm volatile("s_waitcnt vmcnt(" #n ")" ::: "memory")
#define PG8_WAIT_L(n) asm volatile("s_waitcnt lgkmcnt(" #n ")" ::: "memory")
#define PG8_BAR __builtin_amdgcn_s_barrier()
#define PG8_SCHED __builtin_amdgcn_sched_barrier(0)
    Unit cur, nxt; int ui = 0;
    if (!S.next(0, cur)) return;
    f32x4 acc[2][2][4][2];
#pragma unroll
    for (int a = 0; a < 2; ++a)
#pragma unroll
        for (int b = 0; b < 2; ++b)
#pragma unroll
            for (int m = 0; m < 4; ++m)
#pragma unroll
                for (int n = 0; n < 2; ++n) acc[a][b][m][n] = (f32x4){0.f, 0.f, 0.f, 0.f};
    bf16x8 At[4][2], B0[2][2], B1[2][2];
    const char* cA = (const char*)g.A + (size_t)cur.pm * tstep; const char* cB = (const char*)g.Bt + (size_t)cur.pn * tstep;
    S.a_ready(cur);
    if constexpr (SP2) {
        PG8_STAGE(PG8_SB(0, 0), cB, voffB); PG8_STAGE(PG8_SB(0, 1), cB + hstep, voffB); PG8_STAGE(PG8_SA(0, 0), cA, voffA); PG8_STAGE(PG8_SA(0, 1), cA + hstep, voffA);
        if (wr == 1) PG8_BAR;
        PG8_WAIT_V(2); PG8_BAR;
        PG8_STAGE(PG8_SB(1, 0), cB + kstep, voffB); PG8_STAGE(PG8_SA(1, 0), cA + kstep, voffA); PG8_STAGE(PG8_SB(1, 1), cB + hstep + kstep, voffB);
        PG8_WAIT_V(6); PG8_BAR;
    } else {
        PG8_STAGE(PG8_SB(0, 0), cB, voffB); PG8_STAGE(PG8_SA(0, 0), cA, voffA); PG8_STAGE(PG8_SB(0, 1), cB + hstep, voffB); PG8_STAGE(PG8_SA(0, 1), cA + hstep, voffA);
        if (wr == 1) PG8_BAR;
        PG8_WAIT_V(4); PG8_BAR;
        PG8_STAGE(PG8_SB(1, 0), cB + kstep, voffB); PG8_STAGE(PG8_SA(1, 0), cA + kstep, voffA); PG8_STAGE(PG8_SB(1, 1), cB + hstep + kstep, voffB);
        PG8_WAIT_V(6); PG8_BAR;
    }
    for (;;) {
        const bool has_next = S.next(ui + 1, nxt);
        const char* nA = has_next ? (const char*)g.A + (size_t)nxt.pm * tstep : cA; const char* nB = has_next ? (const char*)g.Bt + (size_t)nxt.pn * tstep : cB;
        for (int t = 0; t < nt; t += 2) {
            const bool last = (t == nt - 2);
            const char* a1 = cA + (size_t)(t + 1) * kstep;
            const char* a2 = last ? nA : cA + (size_t)(t + 2) * kstep; const char* b2 = last ? nB : cB + (size_t)(t + 2) * kstep;
            const char* a3 = a2 + kstep; const char* b3 = b2 + kstep;
            if (last && has_next) S.a_ready(nxt);
            if constexpr (SP2) {
            PG8_LDB(B0, 0, 0); PG8_LDB(B1, 0, 1); PG8_SCHED; PG8_LDA(At, 0, 0); PG8_STAGE(PG8_SA(1, 1), a1 + hstep, voffA);
            PG8_WAIT_V(8); PG8_WAIT_L(0); PG8_BAR; PG8_MMA(0, 0, At, B0); PG8_MMA(0, 1, At, B1); PG8_BAR; PG8_SCHED;
            PG8_LDA(At, 0, 1); PG8_STAGE(PG8_SB(0, 0), b2, voffB); PG8_STAGE(PG8_SB(0, 1), b2 + hstep, voffB); PG8_STAGE(PG8_SA(0, 0), a2, voffA);
            PG8_WAIT_V(8); PG8_WAIT_L(0); PG8_BAR; PG8_MMA(1, 0, At, B0); PG8_MMA(1, 1, At, B1); PG8_BAR; PG8_SCHED;
            PG8_LDB(B0, 1, 0); PG8_LDB(B1, 1, 1); PG8_SCHED; PG8_LDA(At, 1, 0); PG8_STAGE(PG8_SA(0, 1), a2 + hstep, voffA);
            PG8_WAIT_V(8); PG8_WAIT_L(0); PG8_BAR; PG8_MMA(0, 0, At, B0); PG8_MMA(0, 1, At, B1); PG8_BAR; PG8_SCHED;
            PG8_LDA(At, 1, 1); PG8_STAGE(PG8_SB(1, 0), b3, voffB); PG8_STAGE(PG8_SB(1, 1), b3 + hstep, voffB); PG8_STAGE(PG8_SA(1, 0), a3, voffA);
            PG8_WAIT_V(8); PG8_WAIT_L(0); PG8_BAR; PG8_MMA(1, 0, At, B0); PG8_MMA(1, 1, At, B1); PG8_BAR; PG8_SCHED;
            } else {
            PG8_LDB(B0, 0, 0); PG8_SCHED; PG8_LDA(At, 0, 0); PG8_STAGE(PG8_SA(1, 1), a1 + hstep, voffA);
            PG8_WAIT_L(8); PG8_BAR; PG8_WAIT_L(0); PG8_MMA(0, 0, At, B0); PG8_BAR; PG8_SCHED;
            PG8_LDB(B1, 0, 1); PG8_STAGE(PG8_SB(0, 0), b2, voffB);
            PG8_BAR; PG8_WAIT_L(0); PG8_MMA(0, 1, At, B1); PG8_BAR;
            PG8_LDA(At, 0, 1); PG8_STAGE(PG8_SA(0, 0), a2, voffA);
            PG8_BAR; PG8_WAIT_L(0); PG8_MMA(1, 0, At, B0); PG8_BAR; PG8_SCHED;
            PG8_STAGE(PG8_SB(0, 1), b2 + hstep, voffB);
            PG8_WAIT_V(6); PG8_BAR; PG8_MMA(1, 1, At, B1); PG8_BAR;
            PG8_LDB(B0, 1, 0); PG8_SCHED; PG8_LDA(At, 1, 0); PG8_STAGE(PG8_SA(0, 1), a2 + hstep, voffA);
            PG8_WAIT_L(8); PG8_BAR; PG8_WAIT_L(0); PG8_MMA(0, 0, At, B0); PG8_BAR; PG8_SCHED;
            PG8_LDB(B1, 1, 1); PG8_STAGE(PG8_SB(1, 0), b3, voffB);
            PG8_BAR; PG8_WAIT_L(0); PG8_MMA(0, 1, At, B1); PG8_BAR;
            PG8_LDA(At, 1, 1); PG8_STAGE(PG8_SA(1, 0), a3, voffA);
            PG8_BAR; PG8_WAIT_L(0); PG8_MMA(1, 0, At, B0); PG8_BAR; PG8_SCHED;
            PG8_STAGE(PG8_SB(1, 1), b3 + hstep, voffB);
            PG8_WAIT_V(6); PG8_BAR; PG8_MMA(1, 1, At, B1); PG8_BAR;
            }
        }
        if constexpr (ALIGN_EPI) { if (wr == 0) PG8_BAR; }
        if constexpr (!Epi::AFTER_DRAIN) { E(acc, cur, wr, wc, fr, fq); S.done(cur); }
        if (!has_next) break;
#pragma unroll
        for (int a = 0; a < 2; ++a)
#pragma unroll
            for (int b = 0; b < 2; ++b)
#pragma unroll
                for (int m = 0; m < 4; ++m)
#pragma unroll
                    for (int n = 0; n < 2; ++n) acc[a][b][m][n] = (f32x4){0.f, 0.f, 0.f, 0.f};
        cur = nxt; cA = nA; cB = nB; ++ui;
        if constexpr (ALIGN_EPI) { if (wr == 1) PG8_BAR; }
    }
    PG8_WAIT_V(0);
    if constexpr (!ALIGN_EPI) { if (wr == 0) PG8_BAR; }
    PG8_BAR;
    if constexpr (Epi::AFTER_DRAIN) { E.fused(acc, cur, wr, wc, fr, fq, lds, wid, lane); S.done(cur); }
#undef PG8_SA
#undef PG8_SB
#undef PG8_STAGE
#undef PG8_LDA
#undef PG8_LDB
#undef PG8_MMA
#undef PG8_WAIT_V
#undef PG8_WAIT_L
#undef PG8_BAR
#undef PG8_SCHED
}
}

#define LAS __attribute__((address_space(3)))
typedef unsigned short bf16_t;
typedef short bf16x8 __attribute__((ext_vector_type(8)));
typedef float f32x4 __attribute__((ext_vector_type(4)));
typedef float f32x2 __attribute__((ext_vector_type(2)));
typedef unsigned u32x4 __attribute__((ext_vector_type(4)));
typedef unsigned u32x2 __attribute__((ext_vector_type(2)));

constexpr int T_TOK = 32768, DM = 1024, SEQL = 8192, FFD = 2816, ZW = 2560;
constexpr size_t ZB = (size_t)T_TOK * 128;
constexpr int LDS_BYTES = 156 * 1024;
constexpr size_t OFF_SSQ = 0;
constexpr size_t OFF_BAR = 524288;
constexpr size_t OFF_W   = 540672;
constexpr size_t W_IN = 0, W_OUT = 2621440, W_UG = 3670016, W_DN = 9437184, W_LAYER = 12320768;
constexpr size_t OFF_XG  = OFF_W + 4 * W_LAYER * 2;
constexpr size_t OFF_U   = OFF_XG + (size_t)T_TOK * DM * 2;
constexpr size_t OFF_G   = OFF_U + (size_t)T_TOK * FFD * 2;
constexpr size_t OFF_Y   = OFF_G;
constexpr size_t OFF_ST  = OFF_G + (size_t)T_TOK * DM * 2;
constexpr size_t OFF_GL  = OFF_ST + 33554432;
constexpr size_t OFF_EU  = OFF_U + (size_t)T_TOK * ZW * 2;
constexpr size_t OFF_EG  = OFF_EU + (size_t)128 * 4 * FFD * 4;
constexpr size_t WS_END  = OFF_G + (size_t)T_TOK * FFD * 2;

struct Args { const float* in[25]; float* out; unsigned char* ws; int ph_lo, ph_hi; };
typedef const __attribute__((address_space(4))) Args* KA;

__device__ __forceinline__ float bf_lo(unsigned w) { return __uint_as_float(w << 16); }
__device__ __forceinline__ float bf_hi(unsigned w) { return __uint_as_float(w & 0xffff0000u); }
__device__ __forceinline__ unsigned pk2(float lo, float hi) { return pg8::cvt_pk_bf16(lo, hi); }
__device__ __forceinline__ unsigned short f2bf(float f) { return (unsigned short)(pk2(f, 0.f) & 0xffffu); }
__device__ __forceinline__ void unpack8(const u32x4 w, float (&f)[8]) {
    f[0] = bf_lo(w.x); f[1] = bf_hi(w.x); f[2] = bf_lo(w.y); f[3] = bf_hi(w.y); f[4] = bf_lo(w.z); f[5] = bf_hi(w.z); f[6] = bf_lo(w.w); f[7] = bf_hi(w.w); }
__device__ __forceinline__ u32x4 pack8(const float (&f)[8]) { u32x4 w; w.x = pk2(f[0], f[1]); w.y = pk2(f[2], f[3]); w.z = pk2(f[4], f[5]); w.w = pk2(f[6], f[7]); return w; }
__device__ __forceinline__ float sigmoidf_(float x) { return __builtin_amdgcn_rcpf(1.0f + __expf(-x)); }
__device__ __forceinline__ float gelu_tanh(float x) { const float u = 1.5957691216057308f * (x + 0.044715f * x * x * x); return x * __builtin_amdgcn_rcpf(1.0f + __expf(-u)); }
#define MFMA16(a, b, c) __builtin_amdgcn_mfma_f32_16x16x32_bf16((a), (b), (c), 0, 0, 0)

#define XB_TMO      128
#define XB_XCNT(j)  (256  + 64 * (j))
#define XB_XSUB(j)  (1280 + 64 * (j))
#define XB_XGEN(j)  (2304 + 64 * (j))
#define XB_TOP      3328
#define XB_TOPGEN   3392
#define XCD_BAR_WORDS 3456
#define XB_SPIN_CAP (1u << 18)

__device__ __forceinline__ unsigned xb_ld(unsigned* p)              { return __hip_atomic_load(p, __ATOMIC_RELAXED, __HIP_MEMORY_SCOPE_AGENT); }
__device__ __forceinline__ unsigned xb_add(unsigned* p, unsigned v) { return __hip_atomic_fetch_add(p, v, __ATOMIC_RELAXED, __HIP_MEMORY_SCOPE_AGENT); }
__device__ __forceinline__ unsigned xb_xcc_id() { return (unsigned)__builtin_amdgcn_s_getreg((3 << 11) | 20) & 0xFu; }
#define XB_SPIN(cond, bar) do { unsigned _sp = 0; while (cond) { __builtin_amdgcn_s_sleep(1); \
    if ((++_sp & 255u) == 0u) { if (xb_ld(&(bar)[XB_TMO])) break; if (_sp > XB_SPIN_CAP) { atomicAdd(&(bar)[XB_TMO], 1u); break; } } } } while (0)

struct XcdBarrier {
    unsigned* bar; unsigned x;
    volatile LAS unsigned* st;
};

__device__ __forceinline__ XcdBarrier xcd_barrier_post(unsigned* bar, volatile LAS unsigned* st) {
    XcdBarrier b; b.bar = bar; b.x = xb_xcc_id(); b.st = st;
    if (threadIdx.x == 0) (void)xb_add(&bar[XB_XCNT(b.x)], 1u);
    return b;
}
__device__ __forceinline__ void xcd_barrier_complete(unsigned* bar, unsigned x, unsigned& nloc, unsigned& nx) {
    const unsigned G = gridDim.x * gridDim.y * gridDim.z;
    unsigned sum, cnt, mine, sp = 0u;
    for (;;) {
        sum = 0u; cnt = 0u; mine = 0u;
#pragma unroll
        for (unsigned j = 0; j < 16; ++j) { const unsigned c = xb_ld(&bar[XB_XCNT(j)]); sum += c; cnt += (c > 0u) ? 1u : 0u; mine = (j == x) ? c : mine; }
        if (sum == G) break;
        __builtin_amdgcn_s_sleep(1);
        if ((++sp & 255u) == 0u) { if (xb_ld(&bar[XB_TMO])) break; if (sp > XB_SPIN_CAP) { atomicAdd(&bar[XB_TMO], 1u); break; } }
    }
    nloc = mine > 0u ? mine : 1u; nx = cnt > 0u ? cnt : 1u;
}

__device__ __forceinline__ void xcd_barrier(const XcdBarrier& b) {
    asm volatile("s_waitcnt vmcnt(0)" ::: "memory");
    __syncthreads();
    if (threadIdx.x == 0) {
        unsigned* bar = b.bar;
        __builtin_amdgcn_s_waitcnt(0);
        unsigned nloc = b.st[0], nx = b.st[1];
        if (nloc == 0u) { xcd_barrier_complete(bar, b.x, nloc, nx); b.st[0] = nloc; b.st[1] = nx; }
        const unsigned old = xb_add(&bar[XB_XSUB(b.x)], 1u);
        const unsigned gen = old / nloc;
        if (old + 1u == (gen + 1u) * nloc) {
            __builtin_amdgcn_fence(__ATOMIC_RELEASE, "agent");
            asm volatile("s_waitcnt vmcnt(0)" ::: "memory");
            const unsigned og = xb_add(&bar[XB_TOP], 1u);
            const unsigned tg = og / nx;
            if (og + 1u == (tg + 1u) * nx) xb_add(&bar[XB_TOPGEN], 1u);
            else XB_SPIN(xb_ld(&bar[XB_TOPGEN]) == tg, bar);
            __builtin_amdgcn_fence(__ATOMIC_ACQUIRE, "agent");
            xb_add(&bar[XB_XGEN(b.x)], 1u);
            asm volatile("s_waitcnt vmcnt(0)" ::: "memory");
        } else {
            XB_SPIN(xb_ld(&bar[XB_XGEN(b.x)]) == gen, bar);
            __builtin_amdgcn_fence(__ATOMIC_ACQUIRE, "agent");
            asm volatile("s_waitcnt vmcnt(0)" ::: "memory");
        }
    }
    __syncthreads();
}


struct TJob { const float* src; const float* gain; bf16_t* dst; int Nsrc, k0, n0, K, mode; };
__device__ __forceinline__ TJob tjob_decode(KA a, int job) {
    TJob J; const int l = job / 752; int j = job - l * 752; const int hl = l >> 1;
    bf16_t* Wl = (bf16_t*)(a->ws + OFF_W) + (size_t)l * W_LAYER;
    if (j < 160) { J.src = ((l & 1) ? a->in[14] : a->in[4]) + (size_t)hl * 1024 * 2560; J.Nsrc = 2560; J.k0 = (j / 10) * 64; J.n0 = (j % 10) * 256; J.dst = Wl + W_IN; J.K = 1024; J.mode = 0; J.gain = a->in[1] + (size_t)l * 1024; return J; }
    j -= 160;
    if (j < 64) { J.src = ((l & 1) ? a->in[15] : a->in[5]) + (size_t)hl * 1024 * 1024; J.Nsrc = 1024; J.k0 = (j / 4) * 64; J.n0 = (j % 4) * 256; J.dst = Wl + W_OUT; J.K = 1024; J.mode = 0; J.gain = nullptr; return J; }
    j -= 64;
    if (j < 352) { const int gate = j >= 176; if (gate) j -= 176; J.src = (gate ? a->in[21] : a->in[20]) + (size_t)l * 1024 * 2816; J.Nsrc = 2816; J.k0 = (j / 11) * 64; J.n0 = (j % 11) * 256; J.dst = Wl + W_UG; J.K = 1024; J.mode = 1 + gate; J.gain = a->in[2] + (size_t)l * 1024; return J; }
    j -= 352;
    J.src = a->in[24] + (size_t)l * 2816 * 1024; J.Nsrc = 1024; J.k0 = (j / 4) * 64; J.n0 = (j % 4) * 256; J.dst = Wl + W_DN; J.K = 2816; J.mode = 0; J.gain = nullptr; return J;
}
__device__ __forceinline__ void tjob_load(const TJob& J, int tid, f32x4 (&v)[4][2], float& g0, float& g1) {
    const int kk = tid >> 4, n4 = (tid & 15) * 4;
#pragma unroll
    for (int s = 0; s < 4; ++s)
#pragma unroll
        for (int p = 0; p < 2; ++p) v[s][p] = *(const f32x4*)(J.src + (size_t)(J.k0 + kk + 32 * p) * J.Nsrc + J.n0 + 64 * s + n4);
    g0 = 1.f; g1 = 1.f; if (J.gain) { g0 = J.gain[J.k0 + kk]; g1 = J.gain[J.k0 + kk + 32]; }
}
__device__ __forceinline__ void phase_prologue(KA a, LAS unsigned char* lds) {
    const int tid = tid_now(), G = gridDim.x, bx = blockIdx.x;
    float* ssq = (float*)(a->ws + OFF_SSQ);
    LAS unsigned short* tile = (LAS unsigned short*)lds;
    {
      constexpr int NJ = 4 * 752; int job = bx; f32x4 v[4][2]; float g0 = 1.f, g1 = 1.f; TJob J = tjob_decode(a, job < NJ ? job : 0);
      if (job < NJ) tjob_load(J, tid, v, g0, g1);
      const int kk = tid >> 4, n4 = (tid & 15) * 4, n = tid >> 3, k8 = (tid & 7) * 8;
      while (job < NJ) {
#pragma unroll
          for (int s = 0; s < 4; ++s)
#pragma unroll
              for (int p = 0; p < 2; ++p) { const f32x4 w = v[s][p] * (p ? g1 : g0); LAS unsigned short* tp = tile + s * 4608 + n4 * 72 + kk + 32 * p;
                  tp[0] = f2bf(w[0]); tp[72] = f2bf(w[1]); tp[144] = f2bf(w[2]); tp[216] = f2bf(w[3]); }
          bf16_t* const cdst = J.dst; const int cK = J.K, ck0 = J.k0, cn0 = J.n0, cmode = J.mode;
          const int nj = job + G;
          if (nj < NJ) { J = tjob_decode(a, nj); tjob_load(J, tid, v, g0, g1); }
          __syncthreads();
#pragma unroll
          for (int s = 0; s < 4; ++s) { const int nn = cn0 + 64 * s + n; const int drow = cmode ? ((nn >> 7) * 256 + (nn & 127) + (cmode - 1) * 128) : nn;
              *(u32x4*)(cdst + (size_t)drow * cK + ck0 + k8) = *(const LAS u32x4*)(tile + s * 4608 + n * 72 + k8); }
          __syncthreads();
          job = nj;
      }
    }
    const int lane = tid & 63, wave = tid >> 6;
    const float* x = a->in[0]; bf16_t* xg = (bf16_t*)(a->ws + OFF_XG);
    { const int STEP = G * 8 * 4; int row0 = bx * 8 + wave; f32x4 v[4][4];
#pragma unroll
      for (int rr = 0; rr < 4; ++rr)
#pragma unroll
          for (int i = 0; i < 4; ++i) { const int rw = (row0 + rr * G * 8 < T_TOK) ? row0 + rr * G * 8 : T_TOK - 1; v[rr][i] = *(const f32x4*)(x + (size_t)rw * 1024 + lane * 4 + 256 * i); }
      for (; row0 < T_TOK; row0 += STEP) {
        f32x4 vn[4][4]; const int nr0 = row0 + STEP;
#pragma unroll
        for (int rr = 0; rr < 4; ++rr)
#pragma unroll
            for (int i = 0; i < 4; ++i) { const int rw = (nr0 + rr * G * 8 < T_TOK) ? nr0 + rr * G * 8 : T_TOK - 1; vn[rr][i] = *(const f32x4*)(x + (size_t)rw * 1024 + lane * 4 + 256 * i); }
#pragma unroll
        for (int rr = 0; rr < 4; ++rr) { const int row = row0 + rr * G * 8; float s = 0.f; if (row >= T_TOK) continue;
#pragma unroll
            for (int i = 0; i < 4; ++i) { u32x2 w; w.x = pk2(v[rr][i][0], v[rr][i][1]); w.y = pk2(v[rr][i][2], v[rr][i][3]); *(u32x2*)(xg + (size_t)row * 1024 + lane * 4 + 256 * i) = w;
                const float y0 = bf_lo(w.x), y1 = bf_hi(w.x), y2 = bf_lo(w.y), y3 = bf_hi(w.y); s += (y0 * y0 + y1 * y1) + (y2 * y2 + y3 * y3); }
#pragma unroll
            for (int o = 32; o >= 1; o >>= 1) s += __shfl_xor(s, o);
            if (lane < 4) ssq[(size_t)row * 4 + lane] = (lane == 0) ? s : 0.f; }
#pragma unroll
        for (int rr = 0; rr < 4; ++rr)
#pragma unroll
            for (int i = 0; i < 4; ++i) v[rr][i] = vn[rr][i];
      } }
}

constexpr int LR_BB = 0, LR_AA = 34816, LR_XB = 69632, LR_WT = 88064, LR_XH = 106496, LR_SEG = 125440, LR_FOLD = 129536, LR_CW = 133632;
__device__ __forceinline__ void lru_load_xh(KA a, int unit, int tid, u32x4 (&pf)[3]) {
    const int h = unit & 7, c = (unit >> 3) & 63, b = unit >> 9; const bf16_t* Z = (const bf16_t*)(a->ws + OFF_U);
#pragma unroll
    for (int k = 0; k < 3; ++k) { const int idx = tid + 512 * k, r = idx >> 3, c8 = (idx & 7) * 8, pos = c * 128 - 3 + r;
        u32x4 w = {0u, 0u, 0u, 0u}; if (idx < 131 * 8 && pos >= 0) w = *(const u32x4*)(Z + (size_t)(h >> 1) * ZB + ((size_t)b * SEQL + pos) * 128 + (h & 1) * 64 + c8);
        pf[k] = w; }
}
__device__ __forceinline__ void lru_unit(KA a, LAS unsigned char* lds, int e, int unit, int pass, bool stage_w, u32x4 (&pf)[3], int next_unit) {
    const int tid = tid_now(), lane = tid & 63, wave = tid >> 6;
    const int h = unit & 7, c = (unit >> 3) & 63, b = unit >> 9;
    const bf16_t* Z = (const bf16_t*)(a->ws + OFF_U);
    f32x2* AGG = (f32x2*)(a->ws + OFF_ST);
    LAS float* BB = (LAS float*)(lds + LR_BB); LAS float* AA = (LAS float*)(lds + LR_AA);
    LAS unsigned short* XB = (LAS unsigned short*)(lds + LR_XB); LAS unsigned short* WT = (LAS unsigned short*)(lds + LR_WT);
    LAS unsigned short* XH = (LAS unsigned short*)(lds + LR_XH);
    LAS f32x2* SEG = (LAS f32x2*)(lds + LR_SEG); LAS f32x2* FOLD = (LAS f32x2*)(lds + LR_FOLD);
    const size_t tok0 = (size_t)b * SEQL + (size_t)c * 128;
    const int ch = tid & 63, seg = tid >> 6;
    const size_t aggbase = ((size_t)b * 64) * 512 + h * 64 + ch;
    f32x2 ag[8]; u32x4 gaw0 = {0u, 0u, 0u, 0u}, gaw1 = {0u, 0u, 0u, 0u};
    if (pass == 2) {
#pragma unroll
        for (int i = 0; i < 8; ++i) ag[i] = AGG[aggbase + (size_t)(seg * 8 + i) * 512];
        const bf16_t* gap = Z + (size_t)(4 + (h >> 1)) * ZB + (tok0 + (tid >> 2)) * 128 + (h & 1) * 64 + (tid & 3) * 16; gaw0 = *(const u32x4*)gap; gaw1 = *(const u32x4*)(gap + 8); }
    float wv[16]; float cv = 0.f;
    if (stage_w) { const float* wa = a->in[8] + (size_t)e * 32768 + h * 4096; const float* wi = a->in[10] + (size_t)e * 32768 + h * 4096;
#pragma unroll
      for (int k = 0; k < 16; ++k) { const int idx = tid + 512 * k; wv[k] = ((idx >> 12) ? wi : wa)[idx & 4095]; }
      const int grp = tid >> 6, cch = tid & 63;
      if (grp < 4) cv = a->in[6][(size_t)e * 2048 + grp * 512 + h * 64 + cch];
      else if (grp == 4) cv = a->in[7][(size_t)e * 512 + h * 64 + cch];
      else if (grp == 5) cv = a->in[9][(size_t)e * 512 + h * 64 + cch];
      else if (grp == 6) cv = a->in[11][(size_t)e * 512 + h * 64 + cch];
      else cv = a->in[12][(size_t)e * 512 + h * 64 + cch]; }
#pragma unroll
    for (int k = 0; k < 3; ++k) { const int idx = tid + 512 * k; if (idx < 131 * 8) *(LAS u32x4*)(XH + (idx >> 3) * 72 + (idx & 7) * 8) = pf[k]; }
    if (stage_w) {
#pragma unroll
      for (int k = 0; k < 16; ++k) { const int idx = tid + 512 * k, gate = idx >> 12, rem = idx & 4095, i = rem >> 6, j = rem & 63; WT[(gate * 64 + j) * 72 + i] = f2bf(wv[k]); }
      LAS float* CWs = (LAS float*)(lds + LR_CW);
      CWs[tid] = ((tid >> 6) == 7) ? __logf(1.0f + __expf(-cv)) : cv; }
    __syncthreads();
    { const int t = tid >> 2, c16 = (tid & 3) * 16;
      const LAS float* cw = (const LAS float*)(lds + LR_CW) + c16; const LAS float* cb = cw + 256;
      float xc[16];
#pragma unroll
      for (int i = 0; i < 4; ++i) { const f32x4 v = *(const LAS f32x4*)(cb + 4 * i); xc[4 * i] = v[0]; xc[4 * i + 1] = v[1]; xc[4 * i + 2] = v[2]; xc[4 * i + 3] = v[3]; }
#pragma unroll
      for (int j = 0; j < 4; ++j) {
          float xv[16]; { float t8[8]; unpack8(*(const LAS u32x4*)(XH + (t + j) * 72 + c16), t8);
#pragma unroll
              for (int i = 0; i < 8; ++i) xv[i] = t8[i];
              unpack8(*(const LAS u32x4*)(XH + (t + j) * 72 + c16 + 8), t8);
#pragma unroll
              for (int i = 0; i < 8; ++i) xv[8 + i] = t8[i]; }
#pragma unroll
          for (int i = 0; i < 4; ++i) { const f32x4 w = *(const LAS f32x4*)(cw + j * 64 + 4 * i);
              xc[4 * i] += w[0] * xv[4 * i]; xc[4 * i + 1] += w[1] * xv[4 * i + 1]; xc[4 * i + 2] += w[2] * xv[4 * i + 2]; xc[4 * i + 3] += w[3] * xv[4 * i + 3]; }
      }
#pragma unroll
      for (int i = 0; i < 4; ++i) *(LAS f32x4*)(BB + t * 68 + c16 + 4 * i) = (f32x4){xc[4 * i], xc[4 * i + 1], xc[4 * i + 2], xc[4 * i + 3]};
      u32x4 w0, w1; w0.x = pk2(xc[0], xc[1]); w0.y = pk2(xc[2], xc[3]); w0.z = pk2(xc[4], xc[5]); w0.w = pk2(xc[6], xc[7]);
      w1.x = pk2(xc[8], xc[9]); w1.y = pk2(xc[10], xc[11]); w1.z = pk2(xc[12], xc[13]); w1.w = pk2(xc[14], xc[15]);
      *(LAS u32x4*)(XB + t * 72 + c16) = w0; *(LAS u32x4*)(XB + t * 72 + c16 + 8) = w1; }
    __syncthreads();
    if (next_unit >= 0) lru_load_xh(a, next_unit, tid, pf);
    { const int r = lane & 15, q = lane >> 4, tb = wave;
      const bf16x8 a0 = *(const LAS bf16x8*)(XB + (tb * 16 + r) * 72 + q * 8), a1 = *(const LAS bf16x8*)(XB + (tb * 16 + r) * 72 + 32 + q * 8);
      const LAS float* ba = (const LAS float*)(lds + LR_CW) + 320; const LAS float* bi = ba + 64; const LAS float* spv = ba + 128;
#pragma unroll
      for (int cb = 0; cb < 4; ++cb) {
          const bf16x8 bA0 = *(const LAS bf16x8*)(WT + (cb * 16 + r) * 72 + q * 8), bA1 = *(const LAS bf16x8*)(WT + (cb * 16 + r) * 72 + 32 + q * 8);
          const bf16x8 bI0 = *(const LAS bf16x8*)(WT + (64 + cb * 16 + r) * 72 + q * 8), bI1 = *(const LAS bf16x8*)(WT + (64 + cb * 16 + r) * 72 + 32 + q * 8);
          f32x4 cA = {0.f, 0.f, 0.f, 0.f}, cI = {0.f, 0.f, 0.f, 0.f};
          cA = MFMA16(a0, bA0, cA); cA = MFMA16(a1, bA1, cA); cI = MFMA16(a0, bI0, cI); cI = MFMA16(a1, bI1, cI);
          const int ch = cb * 16 + r; const float bav = ba[ch], biv = bi[ch], sp = spv[ch];
#pragma unroll
          for (int j2 = 0; j2 < 2; ++j2) {
              const int t0 = tb * 16 + q * 4 + 2 * j2;
              const f32x2 xa = {cA[2 * j2] + bav, cA[2 * j2 + 1] + bav}, xi = {cI[2 * j2] + biv, cI[2 * j2 + 1] + biv};
              const f32x2 ea = xa * (-1.44269504f), ei = xi * (-1.44269504f);
              f32x2 da, di; da.x = 1.0f + __builtin_amdgcn_exp2f(ea.x); da.y = 1.0f + __builtin_amdgcn_exp2f(ea.y); di.x = 1.0f + __builtin_amdgcn_exp2f(ei.x); di.y = 1.0f + __builtin_amdgcn_exp2f(ei.y);
              f32x2 ra, ig; ra.x = __builtin_amdgcn_rcpf(da.x); ra.y = __builtin_amdgcn_rcpf(da.y); ig.x = __builtin_amdgcn_rcpf(di.x); ig.y = __builtin_amdgcn_rcpf(di.y);
              const f32x2 l2 = ra * (-8.0f * 1.44269504f * sp);
              f32x2 av; av.x = __builtin_amdgcn_exp2f(l2.x); av.y = __builtin_amdgcn_exp2f(l2.y);
              f32x2 om = 1.0f - av * av; om.x = fmaxf(om.x, 1e-30f); om.y = fmaxf(om.y, 1e-30f);
              f32x2 rq; rq.x = __builtin_amdgcn_rsqf(om.x); rq.y = __builtin_amdgcn_rsqf(om.y);
              f32x2 mult = om * rq;
              if (c == 0 && t0 == 0) mult.x = 1.0f;
              const f32x2 xcv = {BB[t0 * 68 + ch], BB[(t0 + 1) * 68 + ch]};
              const f32x2 bv = (mult * ig) * xcv;
              AA[t0 * 68 + ch] = av.x; AA[(t0 + 1) * 68 + ch] = av.y; BB[t0 * 68 + ch] = bv.x; BB[(t0 + 1) * 68 + ch] = bv.y; }
      } }
    __syncthreads();
    { float hh = 0.f, P = 1.f;
#pragma unroll 4
      for (int i = 0; i < 16; ++i) { const int t = seg * 16 + i; const float av = AA[t * 68 + ch], bv = BB[t * 68 + ch]; hh = av * hh + bv; P *= av; BB[t * 68 + ch] = hh; AA[t * 68 + ch] = P; }
      SEG[seg * 64 + ch] = (f32x2){P, hh}; }
    if (pass == 1) {
        __syncthreads();
        if (tid < 64) { float P = 1.f, hh = 0.f;
#pragma unroll
            for (int s = 0; s < 8; ++s) { const f32x2 sg = SEG[s * 64 + ch]; hh = sg.x * hh + sg.y; P *= sg.x; }
            AGG[aggbase + (size_t)c * 512] = (f32x2){P, hh}; }
        __syncthreads();
        return;
    }
    { float P = 1.f, hh = 0.f;
#pragma unroll
      for (int i = 0; i < 8; ++i) { const int cc = seg * 8 + i; const bool use = cc < c; const float p = use ? ag[i].x : 1.f, q = use ? ag[i].y : 0.f; hh = p * hh + q; P *= p; }
      FOLD[seg * 64 + ch] = (f32x2){P, hh}; }
    __syncthreads();
    { float hin = 0.f;
#pragma unroll
      for (int s = 0; s < 8; ++s) { const f32x2 f = FOLD[s * 64 + ch]; hin = f.x * hin + f.y; }
#pragma unroll
      for (int s = 0; s < 8; ++s) { if (s < seg) { const f32x2 sg = SEG[s * 64 + ch]; hin = sg.x * hin + sg.y; } }
#pragma unroll 4
      for (int i = 0; i < 16; ++i) { const int t = seg * 16 + i; BB[t * 68 + ch] += AA[t * 68 + ch] * hin; } }
    __syncthreads();
    { const int t = tid >> 2, c16 = (tid & 3) * 16; bf16_t* Y = (bf16_t*)(a->ws + OFF_Y);
      float g0[8], g1[8]; unpack8(gaw0, g0); unpack8(gaw1, g1);
      float y0[8], y1[8];
#pragma unroll
      for (int i4 = 0; i4 < 2; ++i4) { const f32x4 hA = *(const LAS f32x4*)(BB + t * 68 + c16 + 4 * i4), hB = *(const LAS f32x4*)(BB + t * 68 + c16 + 8 + 4 * i4);
#pragma unroll
          for (int j = 0; j < 4; ++j) { y0[4 * i4 + j] = hA[j] * gelu_tanh(g0[4 * i4 + j]); y1[4 * i4 + j] = hB[j] * gelu_tanh(g1[4 * i4 + j]); } }
      bf16_t* yp = Y + (tok0 + t) * 1024 + h * 64 + c16;
      *(u32x4*)yp = pack8(y0); *(u32x4*)(yp + 8) = pack8(y1); }
    __syncthreads();
}
__device__ __forceinline__ void sconv_unit(KA a, int e, int unit) {
    const int tid = tid_now(), c8 = (tid & 63) * 8, tt = tid >> 6;
    const bf16_t* Z = (const bf16_t*)(a->ws + OFF_U); bf16_t* Y = (bf16_t*)(a->ws + OFF_Y);
    const float* sw = a->in[13] + (size_t)e * 1536 + c8;
    float w[3][8];
#pragma unroll
    for (int j = 0; j < 3; ++j) { const f32x4 v0 = *(const f32x4*)(sw + j * 512), v1 = *(const f32x4*)(sw + j * 512 + 4);
        w[j][0] = v0[0]; w[j][1] = v0[1]; w[j][2] = v0[2]; w[j][3] = v0[3]; w[j][4] = v1[0]; w[j][5] = v1[1]; w[j][6] = v1[2]; w[j][7] = v1[3]; }
    const bf16_t* zb = Z + (size_t)(c8 >> 7) * ZB + (c8 & 127);
    u32x4 hbw[4][3], cgw[4][3], bgw[4];
#pragma unroll
    for (int rr = 0; rr < 4; ++rr) { const int tok = unit * 32 + rr * 8 + tt, pos = tok & (SEQL - 1);
#pragma unroll
        for (int j = 0; j < 3; ++j) { const int d = 2 - j; const bf16_t* zr = zb + (size_t)((pos >= d) ? tok - d : tok) * 128;
            hbw[rr][j] = *(const u32x4*)(zr + 8 * ZB); cgw[rr][j] = *(const u32x4*)(zr + 16 * ZB); }
        bgw[rr] = *(const u32x4*)(zb + 12 * ZB + (size_t)tok * 128); }
#pragma unroll
    for (int rr = 0; rr < 4; ++rr) { const int tok = unit * 32 + rr * 8 + tt, pos = tok & (SEQL - 1);
        float acc[8];
#pragma unroll
        for (int i = 0; i < 8; ++i) acc[i] = 0.f;
#pragma unroll
        for (int j = 0; j < 3; ++j) { const float msk = (pos >= 2 - j) ? 1.0f : 0.0f; float hb[8], cgv[8]; unpack8(hbw[rr][j], hb); unpack8(cgw[rr][j], cgv);
#pragma unroll
            for (int i = 0; i < 8; ++i) acc[i] += (w[j][i] * msk) * (cgv[i] * hb[i]); }
        float bg[8]; unpack8(bgw[rr], bg);
#pragma unroll
        for (int i = 0; i < 8; ++i) acc[i] *= bg[i];
        *(u32x4*)(Y + (size_t)tok * 1024 + 512 + c8) = pack8(acc);
    }
}

constexpr int PL_UH = 0, PL_PA = 38912, PL_WT = 73728;
__device__ __forceinline__ void pool_load_uh(KA a, int unit, int tid, u32x4 (&pf)[5]) {
    const int g = unit & 3, tile = unit >> 2; const int tok0 = tile * 128, pos0 = tok0 & (SEQL - 1); const bf16_t* Z = (const bf16_t*)(a->ws + OFF_U);
#pragma unroll
    for (int k = 0; k < 5; ++k) { const int idx = tid + 512 * k, r = idx >> 4, c8 = (idx & 15) * 8, pos = pos0 - 15 + r;
        u32x4 w = {0u, 0u, 0u, 0u}; if (idx < 143 * 16 && pos >= 0) w = *(const u32x4*)(Z + (size_t)g * ZB + (size_t)(tok0 - 15 + r) * 128 + c8);
        pf[k] = w; }
}
__device__ __forceinline__ void pool_unit(KA a, LAS unsigned char* lds, int o, int unit, bool stage_w, u32x4 (&pf)[5], int next_unit) {
    const int tid = tid_now(), lane = tid & 63, wave = tid >> 6;
    const int g = unit & 3, tile = unit >> 2; const int tok0 = tile * 128, pos0 = tok0 & (SEQL - 1);
    const bf16_t* Z = (const bf16_t*)(a->ws + OFF_U); bf16_t* Y = (bf16_t*)(a->ws + OFF_Y);
    LAS unsigned short* UH = (LAS unsigned short*)(lds + PL_UH); LAS unsigned short* PA = (LAS unsigned short*)(lds + PL_PA); LAS unsigned short* WT = (LAS unsigned short*)(lds + PL_WT);
#pragma unroll
    for (int k = 0; k < 5; ++k) { const int idx = tid + 512 * k; if (idx < 143 * 16) *(LAS u32x4*)(UH + (idx >> 4) * 136 + (idx & 15) * 8) = pf[k]; }
    if (stage_w) { const float* pw = a->in[16] + (size_t)o * 65536 + g * 16384;
#pragma unroll
      for (int kb = 0; kb < 2; ++kb) { float wv[16];
#pragma unroll
          for (int k = 0; k < 16; ++k) wv[k] = pw[tid + 512 * (kb * 16 + k)];
#pragma unroll
          for (int k = 0; k < 16; ++k) { const int idx = tid + 512 * (kb * 16 + k), i = idx >> 7, oo = idx & 127; WT[oo * 136 + i] = f2bf(wv[k]); } } }
    __syncthreads();
    {
      const int c8 = (tid & 15) * 8, tg = (tid >> 4) * 4; const int win = 2 << g;
      float s[8];
#pragma unroll
      for (int i = 0; i < 8; ++i) s[i] = 0.f;
      for (int k = 0; k < win; ++k) { float v[8]; unpack8(*(const LAS u32x4*)(UH + (tg + 15 - k) * 136 + c8), v);
#pragma unroll
          for (int i = 0; i < 8; ++i) s[i] += v[i]; }
#pragma unroll
      for (int tt = 0; tt < 4; ++tt) { const int t = tg + tt; float u0[8]; unpack8(*(const LAS u32x4*)(UH + (t + 15) * 136 + c8), u0);
          if (tt > 0) { float ul[8]; unpack8(*(const LAS u32x4*)(UH + (t + 15 - win) * 136 + c8), ul);
#pragma unroll
              for (int i = 0; i < 8; ++i) s[i] += u0[i] - ul[i]; }
          const int pos = pos0 + t; const int n = (pos + 1 < win) ? pos + 1 : win; const float inv = __builtin_amdgcn_rcpf((float)n);
          float p[8];
#pragma unroll
          for (int i = 0; i < 8; ++i) p[i] = s[i] * inv - u0[i];
          *(LAS u32x4*)(PA + t * 136 + c8) = pack8(p); } }
    __syncthreads();
    if (next_unit >= 0) pool_load_uh(a, next_unit, tid, pf);
    { const int r = lane & 15, q = lane >> 4, tb = wave;
      bf16x8 af[4];
#pragma unroll
      for (int ks = 0; ks < 4; ++ks) af[ks] = *(const LAS bf16x8*)(PA + (tb * 16 + r) * 136 + ks * 32 + q * 8);
      const float* sc = a->in[17] + (size_t)o * 512 + g * 128;
#pragma unroll
      for (int ob = 0; ob < 8; ++ob) { f32x4 cc = {0.f, 0.f, 0.f, 0.f};
#pragma unroll
          for (int ks = 0; ks < 4; ++ks) cc = MFMA16(af[ks], *(const LAS bf16x8*)(WT + (ob * 16 + r) * 136 + ks * 32 + q * 8), cc);
          const float s = sc[ob * 16 + r];
#pragma unroll
          for (int jj = 0; jj < 4; ++jj) PA[(tb * 16 + q * 4 + jj) * 136 + ob * 16 + r] = f2bf(cc[jj] * s); }
      { const int rr = lane >> 2, c32 = (lane & 3) * 32;
#pragma unroll
        for (int k = 0; k < 4; ++k) *(u32x4*)(Y + (size_t)(tok0 + tb * 16 + rr) * 1024 + g * 128 + c32 + 8 * k) = *(const LAS u32x4*)(PA + (tb * 16 + rr) * 136 + c32 + 8 * k); } }
    __syncthreads();
}

constexpr int HG_QT = 0, HG_KT = 17408, HG_QP = 34816, HG_KTT = 52224, HG_VT = 70656, HG_AM = 89088, HG_SB = 98304, HG_DL = 133120, HG_EL = 133632, HG_LB = 134144, HG_GLS = 134656, HG_NG = 135168;
__device__ __forceinline__ float wave_scan_incl(float x) {
    x += __int_as_float(__builtin_amdgcn_update_dpp(0, __float_as_int(x), 0x111, 0xf, 0xf, true));
    x += __int_as_float(__builtin_amdgcn_update_dpp(0, __float_as_int(x), 0x112, 0xf, 0xf, true));
    x += __int_as_float(__builtin_amdgcn_update_dpp(0, __float_as_int(x), 0x114, 0xf, 0xf, true));
    x += __int_as_float(__builtin_amdgcn_update_dpp(0, __float_as_int(x), 0x118, 0xf, 0xf, true));
    x += __int_as_float(__builtin_amdgcn_update_dpp(0, __float_as_int(x), 0x142, 0xa, 0xf, false));
    x += __int_as_float(__builtin_amdgcn_update_dpp(0, __float_as_int(x), 0x143, 0xc, 0xf, false));
    return x;
}
__device__ __forceinline__ void hgrn_load_first(KA a, int unit, int tid, int pass, u32x4 (&nx)[6]) {
    const int lane = tid & 63, wave = tid >> 6, h = unit & 3, blk = (unit >> 2) & 31, b = unit >> 7;
    const bf16_t* zl = (const bf16_t*)(a->ws + OFF_U) + (size_t)h * ZB + ((size_t)b * SEQL + blk * 256 + lane) * 128 + wave * 16;
    nx[0] = *(const u32x4*)(zl + 8 * ZB); nx[1] = *(const u32x4*)(zl + 8 * ZB + 8); nx[2] = *(const u32x4*)(zl + 12 * ZB); nx[3] = *(const u32x4*)(zl + 12 * ZB + 8);
    if (pass == 2) { nx[4] = *(const u32x4*)(zl + 4 * ZB); nx[5] = *(const u32x4*)(zl + 4 * ZB + 8); } else { nx[4] = (u32x4){0u, 0u, 0u, 0u}; nx[5] = (u32x4){0u, 0u, 0u, 0u}; }
}
__device__ __forceinline__ void hgrn_unit(KA a, LAS unsigned char* lds, int o, int unit, int pass, u32x4 (&nx)[6], int next_unit) {
    const int tid = tid_now(), lane = tid & 63, wave = tid >> 6, r = lane & 15, q = lane >> 4;
    const int h = unit & 3, blk = (unit >> 2) & 31, b = unit >> 7;
    const bf16_t* Z = (const bf16_t*)(a->ws + OFF_U); bf16_t* Y = (bf16_t*)(a->ws + OFF_Y);
    float* DS = (float*)(a->ws + OFF_ST) + ((size_t)((b * 32 + blk) * 4 + h)) * 16384;
    float* GLB = (float*)(a->ws + OFF_GL) + ((size_t)((b * 32 + blk) * 4 + h)) * 128;
    LAS float* Os = (LAS float*)(lds + HG_QT);
    LAS unsigned short* QT = (LAS unsigned short*)(lds + HG_QT); LAS unsigned short* KT = (LAS unsigned short*)(lds + HG_KT); LAS unsigned short* QP = (LAS unsigned short*)(lds + HG_QP);
    LAS unsigned short* KTT = (LAS unsigned short*)(lds + HG_KTT); LAS unsigned short* VT = (LAS unsigned short*)(lds + HG_VT);
    LAS unsigned short* AM = (LAS unsigned short*)(lds + HG_AM); LAS unsigned short* SB = (LAS unsigned short*)(lds + HG_SB);
    LAS float* DL = (LAS float*)(lds + HG_DL); LAS float* EL = (LAS float*)(lds + HG_EL); LAS float* LBS = (LAS float*)(lds + HG_LB); LAS float* GLS = (LAS float*)(lds + HG_GLS); LAS float* NGS = (LAS float*)(lds + HG_NG);
    const int t = tid >> 3, d0 = (tid & 7) * 16;
    if (tid < 128) { float v = 0.f; if (o == 1) { const float l0 = a->in[18][h * 128 + tid], l1 = a->in[18][512 + h * 128 + tid]; v = 1.0f / (1.0f + __expf(l0 - l1)); } LBS[tid] = 1.0f - v; GLS[tid] = 0.f; NGS[tid] = a->in[19][(size_t)o * 512 + h * 128 + tid]; }
    __syncthreads();
    f32x4 St[8];
#pragma unroll
    for (int kb = 0; kb < 8; ++kb) { if (pass == 2) {
#pragma unroll
            for (int jj = 0; jj < 4; ++jj) St[kb][jj] = DS[(wave * 16 + q * 4 + jj) * 128 + kb * 16 + r]; } else St[kb] = (f32x4){0.f, 0.f, 0.f, 0.f}; }
    const bf16_t* zl = Z + (size_t)h * ZB + ((size_t)b * SEQL + blk * 256 + lane) * 128 + wave * 16;
    u32x4 nfw0 = nx[0], nfw1 = nx[1], nvw0 = nx[2], nvw1 = nx[3], nqw0 = nx[4], nqw1 = nx[5];
    const int tsw = (((lane >> 3) ^ wave) << 3) + (lane & 7);
    for (int s = 0; s < 4; ++s) {
        const size_t row = (size_t)b * SEQL + blk * 256 + s * 64 + t;
        const u32x4 fw0 = nfw0, fw1 = nfw1, qw0 = nqw0, qw1 = nqw1, vw0 = nvw0, vw1 = nvw1;
        if (s < 3) { const bf16_t* zn = zl + (size_t)(s + 1) * 64 * 128;
            nfw0 = *(const u32x4*)(zn + 8 * ZB); nfw1 = *(const u32x4*)(zn + 8 * ZB + 8); nvw0 = *(const u32x4*)(zn + 12 * ZB); nvw1 = *(const u32x4*)(zn + 12 * ZB + 8);
            if (pass == 2) { nqw0 = *(const u32x4*)(zn + 4 * ZB); nqw1 = *(const u32x4*)(zn + 4 * ZB + 8); } }
        else if (next_unit >= 0) hgrn_load_first(a, next_unit, tid, pass, nx);
#pragma unroll
        for (int hv = 0; hv < 2; ++hv) { const int dd = wave * 16 + hv * 8;
            float fz[8], qq[8], vv[8], qt[8], kt[8], qp[8]; unpack8(hv ? fw1 : fw0, fz); unpack8(hv ? qw1 : qw0, qq); unpack8(hv ? vw1 : vw0, vv);
            float glv = 0.f, grv = 0.f;
#pragma unroll
            for (int i = 0; i < 8; i += 2) {
                const f32x2 lbv = *(const LAS f32x2*)(LBS + dd + i);
                const f32x2 e2 = (f32x2){fz[i], fz[i + 1]} * 1.44269504f;
                f32x2 dn; dn.x = 1.0f + __builtin_amdgcn_exp2f(e2.x); dn.y = 1.0f + __builtin_amdgcn_exp2f(e2.y);
                f32x2 rc; rc.x = __builtin_amdgcn_rcpf(dn.x); rc.y = __builtin_amdgcn_rcpf(dn.y);
                const f32x2 kk = lbv * rc;
                f32x2 om = 1.0f - kk; om.x = fmaxf(om.x, 1e-20f); om.y = fmaxf(om.y, 1e-20f);
                f32x2 g2; g2.x = wave_scan_incl(__builtin_amdgcn_logf(om.x)); g2.y = wave_scan_incl(__builtin_amdgcn_logf(om.y));
                f32x2 gr, gl2; gr.x = __int_as_float(__builtin_amdgcn_readlane(__float_as_int(g2.x), 31)); gr.y = __int_as_float(__builtin_amdgcn_readlane(__float_as_int(g2.y), 31));
                gl2.x = __int_as_float(__builtin_amdgcn_readlane(__float_as_int(g2.x), 63)); gl2.y = __int_as_float(__builtin_amdgcn_readlane(__float_as_int(g2.y), 63));
                f32x2 a1 = g2 - gr, a2 = gr - g2; a1.x = fminf(a1.x, 115.f); a1.y = fminf(a1.y, 115.f); a2.x = fminf(a2.x, 115.f); a2.y = fminf(a2.y, 115.f);
                f32x2 E0, E1, E2; E0.x = __builtin_amdgcn_exp2f(g2.x); E0.y = __builtin_amdgcn_exp2f(g2.y); E1.x = __builtin_amdgcn_exp2f(a1.x); E1.y = __builtin_amdgcn_exp2f(a1.y); E2.x = __builtin_amdgcn_exp2f(a2.x); E2.y = __builtin_amdgcn_exp2f(a2.y);
                const f32x2 qv = {qq[i], qq[i + 1]}; const f32x2 qpv = qv * E0, qtv = qv * E1, ktv = kk * E2;
                qp[i] = qpv.x; qp[i + 1] = qpv.y; qt[i] = qtv.x; qt[i + 1] = qtv.y; kt[i] = ktv.x; kt[i + 1] = ktv.y;
                glv = (lane == i) ? gl2.x : glv; grv = (lane == i) ? gr.x : grv; glv = (lane == i + 1) ? gl2.y : glv; grv = (lane == i + 1) ? gr.y : grv;
                KTT[(dd + i) * 72 + tsw] = f2bf(kt[i]); VT[(dd + i) * 72 + tsw] = f2bf(vv[i]); KTT[(dd + i + 1) * 72 + tsw] = f2bf(kt[i + 1]); VT[(dd + i + 1) * 72 + tsw] = f2bf(vv[i + 1]); }
            if (lane < 8) { DL[dd + lane] = __builtin_amdgcn_exp2f(glv); EL[dd + lane] = __builtin_amdgcn_exp2f(glv - grv); GLS[dd + lane] += glv * 0.69314718f; }
            if (pass == 2) { *(LAS u32x4*)(QT + lane * 136 + dd) = pack8(qt); *(LAS u32x4*)(KT + lane * 136 + dd) = pack8(kt); *(LAS u32x4*)(QP + lane * 136 + dd) = pack8(qp); } }
        if (pass == 2) {
#pragma unroll
            for (int kb = 0; kb < 8; ++kb)
#pragma unroll
                for (int jj = 0; jj < 4; ++jj) SB[(wave * 16 + q * 4 + jj) * 136 + kb * 16 + r] = f2bf(St[kb][jj]); }
        __syncthreads();
        u32x4 gdw0 = {0u, 0u, 0u, 0u}, gdw1 = {0u, 0u, 0u, 0u};
        if (pass == 2) { const bf16_t* zg = Z + (size_t)h * ZB + row * 128 + d0 + 16 * ZB; gdw0 = *(const u32x4*)zg; gdw1 = *(const u32x4*)(zg + 8); }
        f32x4 oacc[4];
        const int ib = wave >> 1, vb0 = (wave & 1) * 4;
        if (pass == 2) {
#pragma unroll
            for (int tt = 0; tt < 2; ++tt) { const int tile = wave * 2 + tt, ia = tile >> 2, jb = tile & 3; f32x4 cc = {0.f, 0.f, 0.f, 0.f};
                if (jb <= ia) {
#pragma unroll
                    for (int ks = 0; ks < 4; ++ks) cc = MFMA16(*(const LAS bf16x8*)(QT + (ia * 16 + r) * 136 + ks * 32 + q * 8), *(const LAS bf16x8*)(KT + (jb * 16 + r) * 136 + ks * 32 + q * 8), cc); }
#pragma unroll
                for (int jj = 0; jj < 4; ++jj) { const int i = ia * 16 + q * 4 + jj, j = jb * 16 + r; AM[i * 72 + j] = f2bf((jb <= ia && j <= i) ? cc[jj] : 0.f); } }
            bf16x8 qa[4];
#pragma unroll
            for (int ks = 0; ks < 4; ++ks) qa[ks] = *(const LAS bf16x8*)(QP + (ib * 16 + r) * 136 + ks * 32 + q * 8);
#pragma unroll
            for (int vi = 0; vi < 4; ++vi) { f32x4 cc = {0.f, 0.f, 0.f, 0.f};
#pragma unroll
                for (int ks = 0; ks < 4; ++ks) cc = MFMA16(qa[ks], *(const LAS bf16x8*)(SB + ((vb0 + vi) * 16 + r) * 136 + ks * 32 + q * 8), cc);
                oacc[vi] = cc; }
            __syncthreads();
            const bf16x8 am0 = *(const LAS bf16x8*)(AM + (ib * 16 + r) * 72 + q * 8), am1 = *(const LAS bf16x8*)(AM + (ib * 16 + r) * 72 + 32 + q * 8);
#pragma unroll
            for (int vi = 0; vi < 4; ++vi) { oacc[vi] = MFMA16(am0, *(const LAS bf16x8*)(VT + ((vb0 + vi) * 16 + r) * 72 + ((q ^ (vb0 + vi)) << 3)), oacc[vi]);
                oacc[vi] = MFMA16(am1, *(const LAS bf16x8*)(VT + ((vb0 + vi) * 16 + r) * 72 + (((4 + q) ^ (vb0 + vi)) << 3)), oacc[vi]); }
        }
        { const bf16x8 va0 = *(const LAS bf16x8*)(VT + (wave * 16 + r) * 72 + ((q ^ wave) << 3)), va1 = *(const LAS bf16x8*)(VT + (wave * 16 + r) * 72 + (((4 + q) ^ wave) << 3));
#pragma unroll
          for (int kb = 0; kb < 8; ++kb) { f32x4 cc = {0.f, 0.f, 0.f, 0.f};
              cc = MFMA16(va0, *(const LAS bf16x8*)(KTT + (kb * 16 + r) * 72 + ((q ^ kb) << 3)), cc); cc = MFMA16(va1, *(const LAS bf16x8*)(KTT + (kb * 16 + r) * 72 + (((4 + q) ^ kb) << 3)), cc);
              const float dl = DL[kb * 16 + r], el = EL[kb * 16 + r]; St[kb] = St[kb] * dl + cc * el; } }
        if (pass == 2) {
#pragma unroll
            for (int vi = 0; vi < 4; ++vi)
#pragma unroll
                for (int jj = 0; jj < 4; ++jj) Os[(ib * 16 + q * 4 + jj) * 132 + (vb0 + vi) * 16 + r] = oacc[vi][jj];
            __syncthreads();
            float ov[16]; float ss = 0.f;
#pragma unroll
            for (int i = 0; i < 4; ++i) { const f32x4 v = *(const LAS f32x4*)(Os + t * 132 + d0 + 4 * i); ov[4 * i] = v[0]; ov[4 * i + 1] = v[1]; ov[4 * i + 2] = v[2]; ov[4 * i + 3] = v[3];
                ss += (v[0] * v[0] + v[1] * v[1]) + (v[2] * v[2] + v[3] * v[3]); }
            ss += __shfl_xor(ss, 1); ss += __shfl_xor(ss, 2); ss += __shfl_xor(ss, 4);
            const float rstd = __builtin_amdgcn_rsqf(ss * (1.0f / 128.0f) + 1e-6f);
            float gd0[8], gd1[8]; unpack8(gdw0, gd0); unpack8(gdw1, gd1);
            const LAS float* ng = NGS + d0;
            float y0[8], y1[8];
#pragma unroll
            for (int i = 0; i < 8; ++i) { y0[i] = ov[i] * rstd * ng[i] * (gd0[i] * sigmoidf_(gd0[i])); y1[i] = ov[8 + i] * rstd * ng[8 + i] * (gd1[i] * sigmoidf_(gd1[i])); }
            bf16_t* yp = Y + row * 1024 + 512 + h * 128 + d0;
            *(u32x4*)yp = pack8(y0); *(u32x4*)(yp + 8) = pack8(y1);
        }
        __syncthreads();
    }
    if (pass == 1) {
#pragma unroll
        for (int kb = 0; kb < 8; ++kb)
#pragma unroll
            for (int jj = 0; jj < 4; ++jj) DS[(wave * 16 + q * 4 + jj) * 128 + kb * 16 + r] = St[kb][jj];
        if (tid < 128) GLB[tid] = GLS[tid];
    }
    __syncthreads();
}
__device__ __forceinline__ void hgrn_scan(KA a) {
    const int G = gridDim.x;
    for (int item = blockIdx.x * 512 + tid_now(); item < 16 * 8192; item += G * 512) {
        const int bh = item >> 13, e2 = item & 8191, bb = bh >> 2, h = bh & 3, k2 = (e2 & 63) * 2;
        f32x2* ds = (f32x2*)((float*)(a->ws + OFF_ST) + ((size_t)(bb * 32 * 4 + h)) * 16384) + e2;
        const f32x2* gl = (const f32x2*)((const float*)(a->ws + OFF_GL) + ((size_t)(bb * 32 * 4 + h)) * 128 + k2);
        f32x2 run = {0.f, 0.f};
#pragma unroll 16
        for (int blk = 0; blk < 32; ++blk) { const f32x2 tmp = ds[(size_t)blk * 4 * 8192]; const f32x2 g = gl[(size_t)blk * 4 * 64];
            ds[(size_t)blk * 4 * 8192] = run; run.x = __expf(g.x) * run.x + tmp.x; run.y = __expf(g.y) * run.y + tmp.y; }
    }
}

__device__ __forceinline__ void phase_act(KA a, int l) {
    const bf16_t* U = (const bf16_t*)(a->ws + OFF_U); bf16_t* Gt = (bf16_t*)(a->ws + OFF_G);
    const float* cw = a->in[22] + (size_t)l * 3 * FFD; const float* cb = a->in[23] + (size_t)l * FFD;
    const int G = gridDim.x;
    for (int item = blockIdx.x * 512 + tid_now(); item < T_TOK * 352; item += G * 512) {
        const int tok = item / 352, c8 = (item - tok * 352) * 8, pos = tok & (SEQL - 1);
        float acc[8]; { const f32x4 b0 = *(const f32x4*)(cb + c8), b1 = *(const f32x4*)(cb + c8 + 4); acc[0] = b0[0]; acc[1] = b0[1]; acc[2] = b0[2]; acc[3] = b0[3]; acc[4] = b1[0]; acc[5] = b1[1]; acc[6] = b1[2]; acc[7] = b1[3]; }
#pragma unroll
        for (int j = 0; j < 3; ++j) { const int d = 2 - j;
            if (pos >= d) { float u[8]; unpack8(*(const u32x4*)(U + (size_t)(tok - d) * FFD + c8), u);
                const f32x4 w0 = *(const f32x4*)(cw + j * FFD + c8), w1 = *(const f32x4*)(cw + j * FFD + c8 + 4);
                acc[0] += w0[0] * u[0]; acc[1] += w0[1] * u[1]; acc[2] += w0[2] * u[2]; acc[3] += w0[3] * u[3]; acc[4] += w1[0] * u[4]; acc[5] += w1[1] * u[5]; acc[6] += w1[2] * u[6]; acc[7] += w1[3] * u[7]; } }
        float gt[8]; unpack8(*(const u32x4*)(Gt + (size_t)tok * FFD + c8), gt);
#pragma unroll
        for (int i = 0; i < 8; ++i) acc[i] = gelu_tanh(acc[i]) * gt[i];
        *(u32x4*)(Gt + (size_t)tok * FFD + c8) = pack8(acc);
    }
}
__device__ __forceinline__ void phase_final(KA a) {
    const float* ssq = (const float*)(a->ws + OFF_SSQ); const float* gf = a->in[3]; float* out = a->out; const bf16_t* X = (const bf16_t*)(a->ws + OFF_XG);
    const int G = gridDim.x, tid = tid_now(), lane = tid & 63, wave = tid >> 6;
    f32x4 g[4];
#pragma unroll
    for (int i = 0; i < 4; ++i) g[i] = *(const f32x4*)(gf + (i >> 1) * 512 + lane * 8 + (i & 1) * 4);
    for (int row0 = blockIdx.x * 8 + wave; row0 < T_TOK; row0 += G * 8 * 4) {
        u32x4 xw[4][2]; f32x4 sq[4];
#pragma unroll
        for (int rr = 0; rr < 4; ++rr) { const int row = (row0 + rr * G * 8 < T_TOK) ? row0 + rr * G * 8 : T_TOK - 1;
            xw[rr][0] = *(const u32x4*)(X + (size_t)row * 1024 + lane * 8); xw[rr][1] = *(const u32x4*)(X + (size_t)row * 1024 + 512 + lane * 8); sq[rr] = *(const f32x4*)(ssq + (size_t)row * 4); }
#pragma unroll
        for (int rr = 0; rr < 4; ++rr) { const int row = row0 + rr * G * 8; if (row >= T_TOK) continue;
            const float rs = rsqrtf(((sq[rr][0] + sq[rr][1]) + (sq[rr][2] + sq[rr][3])) * (1.0f / 1024.0f) + 1e-6f);
#pragma unroll
            for (int hh = 0; hh < 2; ++hh) { float xv[8]; unpack8(xw[rr][hh], xv); float* op = out + (size_t)row * 1024 + hh * 512 + lane * 8;
                *(f32x4*)op = (f32x4){xv[0], xv[1], xv[2], xv[3]} * rs * g[2 * hh]; *(f32x4*)(op + 4) = (f32x4){xv[4], xv[5], xv[6], xv[7]} * rs * g[2 * hh + 1]; } }
    }
}
__device__ __forceinline__ void act_fixup(KA a, int l, int pm) {
    const float* EU = (const float*)(a->ws + OFF_EU); const float* EG = (const float*)(a->ws + OFF_EG); bf16_t* ACT = (bf16_t*)(a->ws + OFF_G);
    const float* cw = a->in[22] + (size_t)l * 3 * FFD; const float* cb = a->in[23] + (size_t)l * FFD;
    const bool first = (pm & 31) == 0;
    const int tid0 = tid_now();
#pragma unroll
    for (int k = 0; k < 11; ++k) { const int e = tid0 + 512 * k; const int rr = e >= FFD ? 1 : 0, col = e - rr * FFD;
        const float u0 = EU[((size_t)(pm * 4 + rr)) * FFD + col];
        const float pl = first ? 0.f : EU[((size_t)((pm - 1) * 4 + 3)) * FFD + col];
        float u1, u2;
        if (rr == 0) { u1 = pl; u2 = first ? 0.f : EU[((size_t)((pm - 1) * 4 + 2)) * FFD + col]; }
        else { u1 = EU[((size_t)(pm * 4)) * FFD + col]; u2 = pl; }
        const float g = EG[((size_t)(pm * 2 + rr)) * FFD + col];
        const float v = gelu_tanh(cb[col] + cw[2 * FFD + col] * u0 + cw[FFD + col] * u1 + cw[col] * u2) * g;
        ACT[((size_t)(pm * 256 + rr)) * FFD + col] = f2bf(v); }
}
#ifndef STAG_N
#define STAG_N 3
#endif
#define STAGGER() do { if ((bx >> 3) & 1) { for (int s_ = 0; s_ < STAG_N; ++s_) __builtin_amdgcn_s_sleep(127); } } while (0)
#ifndef REP_G1_SKIP
#define REP_G1_SKIP 0
#endif
#ifndef REP_BAR
#define REP_BAR 1
#endif
#ifndef REP_LRU1
#define REP_LRU1 1
#endif
#ifndef REP_SCONV
#define REP_SCONV 1
#endif
#ifndef REP_LRU2
#define REP_LRU2 1
#endif
#ifndef REP_HG1
#define REP_HG1 1
#endif
#ifndef REP_POOL
#define REP_POOL 1
#endif
#ifndef REP_HG2
#define REP_HG2 1
#endif
#ifndef G1_ALIGN
#define G1_ALIGN true
#endif
#ifndef REP_SYNC
#define REP_SYNC 1
#endif
#ifndef REP_G1
#define REP_G1 1
#endif
#ifndef REP_EVEN
#define REP_EVEN 1
#endif
#ifndef REP_ODD
#define REP_ODD 1
#endif
#ifndef REP_PRO
#define REP_PRO 1
#endif
#ifndef REP_G3
#define REP_G3 1
#endif
__global__ void __launch_bounds__(512, 2) mega_fwd(Args a_byval) {
    extern __shared__ __attribute__((aligned(16))) unsigned char lds_raw[];
    LAS unsigned char* lds = (LAS unsigned char*)lds_raw;
    cg::grid_group grid = cg::this_grid();
    KA a0 = (KA)__builtin_amdgcn_kernarg_segment_ptr();
    volatile LAS unsigned* xst = (volatile LAS unsigned*)(lds + LDS_BYTES - 256);
    if (threadIdx.x < 4) xst[threadIdx.x] = 0u;
    __syncthreads();
    if (blockIdx.x == 0) { unsigned* bw = (unsigned*)(a0->ws + OFF_BAR); for (int i = threadIdx.x; i < XCD_BAR_WORDS; i += 512) bw[i] = 0u; }
    XcdBarrier xbar; xbar.bar = (unsigned*)(a0->ws + OFF_BAR); xbar.x = 0u; xbar.st = xst;
    const int G = gridDim.x, bx = blockIdx.x;
    const int ph_lo = a0->ph_lo, ph_hi = a0->ph_hi;
    for (int ph = ph_lo; ph < ph_hi; ++ph) {
        bool did = true;
        KA a = a0; asm volatile("" : "+s"(a));
        float* ssq = (float*)(a->ws + OFF_SSQ);
        bf16_t* XG = (bf16_t*)(a->ws + OFF_XG); bf16_t* Ub = (bf16_t*)(a->ws + OFF_U); bf16_t* Gb = (bf16_t*)(a->ws + OFF_G);
        if (ph == 0) { for (int rep = 0; rep < REP_PRO; ++rep) phase_prologue(a, lds); }
        else if (ph == 33) phase_final(a);
        else {
            const int l = (ph - 1) >> 3, s = (ph - 1) & 7, odd = l & 1, hl = l >> 1;
            const bf16_t* Wl = (const bf16_t*)(a->ws + OFF_W) + (size_t)l * W_LAYER;
            if (s == 0) {
                pg8::Gemm g{XG, Wl + W_IN, T_TOK, ZW, DM}; pg8::StaticOrder S; S.init(T_TOK, ZW, G, bx);
                pg8::EpiScale E{Ub, ZW, ssq, 0};
                for (int rep = 0; rep < REP_G1; ++rep) { E.skip = (rep > 0) ? REP_G1_SKIP : 0; pg8::gemm_phase<pg8::EpiScale, pg8::StaticOrder, G1_ALIGN, true>(lds, g, S, E); }
            } else if (s == 1) { for (int rep = 0; rep < (odd ? REP_ODD : REP_EVEN); ++rep) {
                if (!odd) { for (int r1 = 0; r1 < REP_LRU1; ++r1) { int ph_ = -1; u32x4 pf[3]; lru_load_xh(a, bx & 2047, tid_now(), pf); for (int u = bx; u < 2048; u += G) { lru_unit(a, lds, hl, u, 1, (u & 7) != ph_, pf, (u + G < 2048) ? u + G : -1); ph_ = u & 7; } }
                            for (int r2 = 0; r2 < REP_SCONV; ++r2) for (int u = bx; u < 1024; u += G) sconv_unit(a, hl, u); }
                else      { for (int r1 = 0; r1 < REP_HG1; ++r1) { u32x4 nx[6]; hgrn_load_first(a, bx & 511, tid_now(), 1, nx); for (int u = bx; u < 512; u += G) hgrn_unit(a, lds, hl, u, 1, nx, (u + G < 512) ? u + G : -1); }
                            for (int r2 = 0; r2 < REP_POOL; ++r2) { int pg_ = -1; u32x4 pq[5]; pool_load_uh(a, bx & 1023, tid_now(), pq); for (int u = bx; u < 1024; u += G) { pool_unit(a, lds, hl, u, (u & 3) != pg_, pq, (u + G < 1024) ? u + G : -1); pg_ = u & 3; } } } }
            } else if (s == 2) {
                if (odd) hgrn_scan(a); else did = false;
            } else if (s == 3) { for (int rep = 0; rep < (odd ? REP_ODD : REP_EVEN); ++rep) {
                if (!odd) { for (int r1 = 0; r1 < REP_LRU2; ++r1) { int ph_ = -1; u32x4 pf[3]; lru_load_xh(a, bx & 2047, tid_now(), pf); for (int u = bx; u < 2048; u += G) { lru_unit(a, lds, hl, u, 2, (u & 7) != ph_, pf, (u + G < 2048) ? u + G : -1); ph_ = u & 7; } } }
                else      { for (int r1 = 0; r1 < REP_HG2; ++r1) { u32x4 nx[6]; hgrn_load_first(a, bx & 511, tid_now(), 2, nx); for (int u = bx; u < 512; u += G) hgrn_unit(a, lds, hl, u, 2, nx, (u + G < 512) ? u + G : -1); } } }
            } else if (s == 4 || s == 7) {
                const bool dn = (s == 7);
                pg8::Gemm g{dn ? Gb : Gb  , Wl + (dn ? W_DN : W_OUT), T_TOK, DM, dn ? FFD : DM}; pg8::StaticOrder S; S.init(T_TOK, DM, G, bx);
                if (dn) { pg8::Unit fu; for (int i = 0; S.next(i, fu); ++i) act_fixup(a, l, fu.pm);
                          asm volatile("s_waitcnt vmcnt(0)" ::: "memory"); __syncthreads(); }
                pg8::EpiRes E{XG, ssq, (LAS float*)(lds + 131072)};
                pg8::gemm_phase<pg8::EpiRes, pg8::StaticOrder, true, true>(lds, g, S, E);
            } else if (s == 5) {
                pg8::Gemm g{XG, Wl + W_UG, T_TOK, 2 * FFD, DM}; pg8::StaticOrder S; S.init(T_TOK, 2 * FFD, G, bx);
                pg8::EpiAct E{Gb, ssq, a->in[22] + (size_t)l * 3 * FFD, a->in[23] + (size_t)l * FFD, (float*)(a->ws + OFF_EU), (float*)(a->ws + OFF_EG), (LAS float*)(lds + 131072)};
                for (int rep = 0; rep < REP_G3; ++rep) pg8::gemm_phase<pg8::EpiAct, pg8::StaticOrder, true, true>(lds, g, S, E);
            } else { did = false; }
        }
        if (did && ph + 1 < ph_hi) { if (ph == 0) { grid.sync(); xbar = xcd_barrier_post((unsigned*)(a0->ws + OFF_BAR), xst); } else { for (int rb = 0; rb < REP_BAR; ++rb) xcd_barrier(xbar); } }
    }
}

#ifndef MK_MULTI
#define MK_MULTI 0
#endif
extern "C" void kernel_launch(void* const* d_in, const int* in_sizes, int n_in, void* d_out, int out_size, void* d_ws, size_t ws_size, hipStream_t stream) {
    static int grid = 0;
    if (grid == 0) {
        if (n_in != 25 || ws_size < WS_END) { fprintf(stderr, "kernel_launch: unexpected n_in %d or ws_size %zu (< %zu)\n", n_in, ws_size, (size_t)WS_END); grid = -1; return; }
        int dev = 0, cus = 0, per_cu = 0;
        if (hipGetDevice(&dev) != hipSuccess || hipDeviceGetAttribute(&cus, hipDeviceAttributeMultiprocessorCount, dev) != hipSuccess) { grid = -1; return; }
        if (hipFuncSetAttribute((const void*)mega_fwd, hipFuncAttributeMaxDynamicSharedMemorySize, LDS_BYTES) != hipSuccess) { fprintf(stderr, "kernel_launch: hipFuncSetAttribute failed\n"); grid = -1; return; }
        if (hipOccupancyMaxActiveBlocksPerMultiprocessor(&per_cu, (const void*)mega_fwd, 512, LDS_BYTES) != hipSuccess || per_cu < 1) fprintf(stderr, "kernel_launch: occupancy query says %d\n", per_cu);
        (void)hipGetLastError();
        grid = cus;
    }
    if (grid < 0) return;
    Args a{};
    for (int i = 0; i < 25; ++i) a.in[i] = (const float*)d_in[i];
    a.out = (float*)d_out; a.ws = (unsigned char*)d_ws;
#if MK_MULTI
    for (int ph = 0; ph < 34; ++ph) { a.ph_lo = ph; a.ph_hi = ph + 1; void* args[] = {&a};
        if (ph >= 1 && ph < 33 && ((ph - 1) & 7) == 2 && (((ph - 1) >> 3) & 1) == 0) continue;
        hipError_t e = hipLaunchCooperativeKernel((const void*)mega_fwd, dim3(grid), dim3(512), args, LDS_BYTES, stream);
        if (e != hipSuccess) { fprintf(stderr, "launch %d failed: %s\n", ph, hipGetErrorString(e)); break; } }
#else
    a.ph_lo = 0; a.ph_hi = 34; void* args[] = {&a};
    hipError_t e = hipLaunchCooperativeKernel((const void*)mega_fwd, dim3(grid), dim3(512), args, LDS_BYTES, stream);
    if (e != hipSuccess) fprintf(stderr, "cooperative launch failed: %s (grid %d)\n", hipGetErrorString(e), grid);
#endif
}
```

```cpp
#include <hip/hip_runtime.h>
#include <hip/hip_cooperative_groups.h>
#include <cstdio>
#include <cstdint>
namespace cg = cooperative_groups;
__device__ __forceinline__ int tid_now() { int t = threadIdx.x; asm volatile("" : "+v"(t)); return t; }
#ifndef PG8_WGM
#define PG8_WGM 8
#endif
#ifndef PG8_NOPRIO
#define PG8_NOPRIO 0
#endif
#if PG8_NOPRIO
#define PG8_PRIO(x) do {} while (0)
#else
#define PG8_PRIO(x) __builtin_amdgcn_s_setprio(x)
#endif
namespace pg8 {
#define PG8_LAS __attribute__((address_space(3)))
typedef unsigned short bf16_t;
typedef short bf16x8 __attribute__((ext_vector_type(8)));
typedef float f32x4 __attribute__((ext_vector_type(4)));
typedef unsigned u32x4 __attribute__((ext_vector_type(4)));
typedef unsigned u32x2 __attribute__((ext_vector_type(2)));
constexpr int BM = 256, BK = 64, HALF = 128, HTB = HALF * BK * 2  , STAGE_BYTES = 8 * HTB, NXCD = 8, WGM = PG8_WGM;

__host__ __device__ __forceinline__ int lds_byte(int r, int c) { const int st = (r >> 4) * 2 + (c >> 5), rr = r & 15, cc = c & 31, ob = rr * 64 + cc * 2; return st * 1024 + (ob ^ (((ob >> 9) & 1) << 5)); }
__host__ __device__ __forceinline__ void stage_rc(int b, int& R, int& C) { const int st = b / 1024, sb = b % 1024, swz = sb ^ (((sb >> 9) & 1) << 5); R = (st >> 1) * 16 + swz / 64; C = (st & 1) * 32 + (swz % 64) / 2; }
__host__ __device__ __forceinline__ int perm32(int rho) { const int n = rho >> 4, i = rho & 15; return 8 * (i >> 2) + 4 * n + (i & 3); }

struct Unit { int pm, pn; };
struct Gemm { const bf16_t* A; const bf16_t* Bt; int M, N, K; };

struct StaticOrder {
    int nM, nN, nwg, G, c;
    __host__ __device__ void init(int M, int N, int G_, int c_) { nM = M / BM; nN = N / BM; nwg = nM * nN; G = G_; c = c_; }
    __host__ __device__ bool next(int i, Unit& u) const {
        const long L = (long)i * G + c; if (L >= nwg) return false;
        int wgid = (int)L; { const int q = nwg / NXCD, r = nwg % NXCD, xcd = wgid % NXCD, off = wgid / NXCD; wgid = (xcd < r ? xcd * (q + 1) : r * (q + 1) + (xcd - r) * q) + off; }
        const int nig = WGM * nN, gid = wgid / nig, fm = gid * WGM, gsz = (nM - fm) < WGM ? (nM - fm) : WGM;
        u.pm = fm + ((wgid % nig) % gsz); u.pn = (wgid % nig) / gsz; return true;
    }
    __device__ __forceinline__ void a_ready(const Unit&) const {}
    __device__ __forceinline__ void done(const Unit&) const {}
};

__device__ __forceinline__ unsigned cvt_pk_bf16(float lo, float hi) { unsigned r; asm volatile("v_cvt_pk_bf16_f32 %0, %1, %2" : "=v"(r) : "v"(lo), "v"(hi)); return r; }

__device__ __forceinline__ float row_rstd(const float* ssq4, int r) {
    const f32x4 a = *(const f32x4*)(ssq4 + (size_t)r * 4);
    return __builtin_amdgcn_rsqf(((a[0] + a[1]) + (a[2] + a[3])) * (1.0f / 1024.0f) + 1e-6f); }
#ifndef Z_NT
#define Z_NT 0
#endif
#if Z_NT
#define ZSTORE(v, p) __builtin_nontemporal_store((v), (p))
#else
#define ZSTORE(v, p) (*(p) = (v))
#endif
struct EpiScale {
    static constexpr bool PERM = true, AFTER_DRAIN = false;
    bf16_t* O; int ldc; const float* ssq; int skip;
    __device__ __forceinline__ void operator()(const f32x4 (&acc)[2][2][4][2], const Unit& u, int wr_, int wc_, int fr_, int fq_) const {
        const int t_ = tid_now(), fr = t_ & 15, fq = (t_ >> 4) & 3, wc = (t_ >> 6) & 3, wr = t_ >> 8;
        if (skip) return;
        const int row0 = u.pm * BM + wr * 64 + fr, col0 = u.pn * BM + wc * 32 + 8 * fq;
#pragma unroll
        for (int ai = 0; ai < 2; ++ai)
#pragma unroll
            for (int m = 0; m < 4; ++m) { const int r = row0 + ai * HALF + m * 16; const float rs = row_rstd(ssq, r);
#pragma unroll
                for (int bj = 0; bj < 2; ++bj) { const f32x4 v0 = acc[ai][bj][m][0] * rs, v1 = acc[ai][bj][m][1] * rs;
                    u32x4 w; w.x = cvt_pk_bf16(v0[0], v0[1]); w.y = cvt_pk_bf16(v0[2], v0[3]); w.z = cvt_pk_bf16(v1[0], v1[1]); w.w = cvt_pk_bf16(v1[2], v1[3]);
                    ZSTORE(w, (u32x4*)(O + ((size_t)(u.pn * 2 + bj) * 32768 + r) * 128 + wc * 32 + 8 * fq)); } }
    }
};
struct EpiUG {
    static constexpr bool PERM = true, AFTER_DRAIN = false;
    bf16_t* U; bf16_t* G; const float* ssq;
    __device__ __forceinline__ void operator()(const f32x4 (&acc)[2][2][4][2], const Unit& u, int wr_, int wc_, int fr_, int fq_) const {
        const int t_ = tid_now(), fr = t_ & 15, fq = (t_ >> 4) & 3, wc = (t_ >> 6) & 3, wr = t_ >> 8;
        const int row0 = u.pm * BM + wr * 64 + fr, col0 = u.pn * HALF + wc * 32 + 8 * fq;
#pragma unroll
        for (int ai = 0; ai < 2; ++ai)
#pragma unroll
            for (int m = 0; m < 4; ++m) { const int r = row0 + ai * HALF + m * 16; const float rs = row_rstd(ssq, r);
#pragma unroll
                for (int bj = 0; bj < 2; ++bj) { const f32x4 v0 = acc[ai][bj][m][0] * rs, v1 = acc[ai][bj][m][1] * rs;
                    u32x4 w; w.x = cvt_pk_bf16(v0[0], v0[1]); w.y = cvt_pk_bf16(v0[2], v0[3]); w.z = cvt_pk_bf16(v1[0], v1[1]); w.w = cvt_pk_bf16(v1[2], v1[3]);
                    *(u32x4*)((bj ? G : U) + (size_t)r * 2816 + col0) = w; } }
    }
};
struct EpiRes {
    static constexpr bool PERM = true, AFTER_DRAIN = false;
    bf16_t* X; float* ssq_next; PG8_LAS float* PS;
    __device__ __forceinline__ void operator()(const f32x4 (&acc)[2][2][4][2], const Unit& u, int wr_, int wc_, int fr_, int fq_) const {
        const int t_ = tid_now(), fr = t_ & 15, fq = (t_ >> 4) & 3, wc = (t_ >> 6) & 3, wr = t_ >> 8;
        const int row0 = u.pm * BM + wr * 64 + fr, col0 = u.pn * BM + wc * 32 + 8 * fq;
#pragma unroll
        for (int ai = 0; ai < 2; ++ai)
#pragma unroll
            for (int m = 0; m < 4; ++m) { const int r = row0 + ai * HALF + m * 16; bf16_t* xp = X + (size_t)r * 1024 + col0; float s = 0.f;
#pragma unroll
                for (int bj = 0; bj < 2; ++bj) {
                    const u32x4 xw = *(const u32x4*)(xp + bj * HALF); const f32x4 a0 = acc[ai][bj][m][0], a1 = acc[ai][bj][m][1];
                    u32x4 w; w.x = cvt_pk_bf16(__uint_as_float(xw.x << 16) + a0[0], __uint_as_float(xw.x & 0xffff0000u) + a0[1]); w.y = cvt_pk_bf16(__uint_as_float(xw.y << 16) + a0[2], __uint_as_float(xw.y & 0xffff0000u) + a0[3]);
                    w.z = cvt_pk_bf16(__uint_as_float(xw.z << 16) + a1[0], __uint_as_float(xw.z & 0xffff0000u) + a1[1]); w.w = cvt_pk_bf16(__uint_as_float(xw.w << 16) + a1[2], __uint_as_float(xw.w & 0xffff0000u) + a1[3]);
                    *(u32x4*)(xp + bj * HALF) = w;
                    const float y0 = __uint_as_float(w.x << 16), y1 = __uint_as_float(w.x & 0xffff0000u), y2 = __uint_as_float(w.y << 16), y3 = __uint_as_float(w.y & 0xffff0000u);
                    const float y4 = __uint_as_float(w.z << 16), y5 = __uint_as_float(w.z & 0xffff0000u), y6 = __uint_as_float(w.w << 16), y7 = __uint_as_float(w.w & 0xffff0000u);
                    s += ((y0 * y0 + y1 * y1) + (y2 * y2 + y3 * y3)) + ((y4 * y4 + y5 * y5) + (y6 * y6 + y7 * y7)); }
                s += __shfl_xor(s, 16); s += __shfl_xor(s, 32);
                if (fq == 0) PS[wc * 256 + ai * HALF + wr * 64 + m * 16 + fr] = s;
                asm volatile("" ::: "memory"); }
        asm volatile("s_waitcnt lgkmcnt(0)" ::: "memory"); __builtin_amdgcn_s_barrier(); asm volatile("" ::: "memory");
        const int tid = (wr * 4 + wc) * 64 + fq * 16 + fr;
        if (tid < 256) ssq_next[(size_t)(u.pm * BM + tid) * 4 + u.pn] = (PS[tid] + PS[256 + tid]) + (PS[512 + tid] + PS[768 + tid]);
    }
};
typedef float f32x2 __attribute__((ext_vector_type(2)));
__device__ __forceinline__ float gelu_tanh_(float x) { const float u = 1.5957691216057308f * (x + 0.044715f * x * x * x); return x * __builtin_amdgcn_rcpf(1.0f + __expf(-u)); }
struct EpiAct {
    static constexpr bool PERM = true, AFTER_DRAIN = false;
    bf16_t* ACT; const float* ssq; const float* cw; const float* cb; float* EU; float* EG; PG8_LAS float* HX;
    __device__ __forceinline__ void operator()(f32x4 (&acc)[2][2][4][2], const Unit& u, int wr_, int wc_, int fr_, int fq_) const {
        const int t_ = tid_now(), fr = t_ & 15, fq = (t_ >> 4) & 3, wc = (t_ >> 6) & 3, wr = t_ >> 8;
        const int lane = fq * 16 + fr;
        const int row0 = u.pm * BM + wr * 64 + fr, col0 = u.pn * HALF + wc * 32 + 8 * fq;
        f32x4 w0[2], w1[2], w2[2], bb[2];
#pragma unroll
        for (int n = 0; n < 2; ++n) { w0[n] = *(const f32x4*)(cw + col0 + 4 * n); w1[n] = *(const f32x4*)(cw + 2816 + col0 + 4 * n); w2[n] = *(const f32x4*)(cw + 2 * 2816 + col0 + 4 * n); bb[n] = *(const f32x4*)(cb + col0 + 4 * n); }
#pragma unroll
        for (int ai = 0; ai < 2; ++ai)
#pragma unroll
            for (int m = 0; m < 4; ++m) { const float rs = row_rstd(ssq, row0 + ai * HALF + m * 16);
#pragma unroll
                for (int bj = 0; bj < 2; ++bj) { acc[ai][bj][m][0] *= rs; acc[ai][bj][m][1] *= rs; } }
        if (fr >= 14) {
#pragma unroll
            for (int ai = 0; ai < 2; ++ai) { PG8_LAS float* hp = HX + ((((ai * 2 + wr) * 4 + wc) * 4 + fq) * 2 + (fr - 14)) * 8;
                *(PG8_LAS f32x4*)hp = acc[ai][0][3][0]; *(PG8_LAS f32x4*)(hp + 4) = acc[ai][0][3][1]; } }
        if (wr == 0 && fr < 2) { float* p = EU + ((size_t)(u.pm * 4 + fr)) * 2816 + col0; *(f32x4*)p = acc[0][0][0][0]; *(f32x4*)(p + 4) = acc[0][0][0][1];
            float* g = EG + ((size_t)(u.pm * 2 + fr)) * 2816 + col0; *(f32x4*)g = acc[0][1][0][0]; *(f32x4*)(g + 4) = acc[0][1][0][1]; }
        if (wr == 1 && fr >= 14) { float* p = EU + ((size_t)(u.pm * 4 + 2 + (fr - 14))) * 2816 + col0; *(f32x4*)p = acc[1][0][3][0]; *(f32x4*)(p + 4) = acc[1][0][3][1]; }
        asm volatile("s_waitcnt lgkmcnt(0)" ::: "memory"); __builtin_amdgcn_s_barrier(); asm volatile("" ::: "memory");
#pragma unroll
        for (int ai = 0; ai < 2; ++ai) {
            f32x4 pR1[2], pR2[2];
            { const int sai = wr ? ai : ai - 1, swr = wr ? 0 : 1;
              if (sai >= 0) { const PG8_LAS float* hp = HX + ((((sai * 2 + swr) * 4 + wc) * 4 + fq) * 2) * 8;
#pragma unroll
                  for (int n = 0; n < 2; ++n) { const f32x4 h14 = *(const PG8_LAS f32x4*)(hp + 4 * n), h15 = *(const PG8_LAS f32x4*)(hp + 8 + 4 * n); pR1[n] = h15; pR2[n] = (fr == 0) ? h14 : h15; } }
              else { pR1[0] = pR1[1] = pR2[0] = pR2[1] = (f32x4){0.f, 0.f, 0.f, 0.f}; } }
#pragma unroll
            for (int m = 0; m < 4; ++m) { u32x4 w;
#pragma unroll
                for (int n = 0; n < 2; ++n) { const f32x4 up = acc[ai][0][m][n], gt = acc[ai][1][m][n]; f32x4 av;
                    { f32x4 u1, u2;
#pragma unroll
                      for (int j = 0; j < 4; ++j) {
                          u1[j] = __int_as_float(__builtin_amdgcn_update_dpp(__float_as_int(pR1[n][j]), __float_as_int(up[j]), 0x111, 0xf, 0xf, false));
                          u2[j] = __int_as_float(__builtin_amdgcn_update_dpp(__float_as_int(pR2[n][j]), __float_as_int(up[j]), 0x112, 0xf, 0xf, false));
                          if (m < 3) { pR1[n][j] = __int_as_float(__builtin_amdgcn_update_dpp(0, __float_as_int(up[j]), 0x121, 0xf, 0xf, true));
                                       pR2[n][j] = __int_as_float(__builtin_amdgcn_update_dpp(0, __float_as_int(up[j]), 0x122, 0xf, 0xf, true)); } }
#pragma unroll
                      for (int hh = 0; hh < 2; ++hh) {
                          const f32x2 upv = {up[2 * hh], up[2 * hh + 1]}, u1v = {u1[2 * hh], u1[2 * hh + 1]}, u2v = {u2[2 * hh], u2[2 * hh + 1]}, gtv = {gt[2 * hh], gt[2 * hh + 1]};
                          const f32x2 bbv = {bb[n][2 * hh], bb[n][2 * hh + 1]}, w0v = {w0[n][2 * hh], w0[n][2 * hh + 1]}, w1v = {w1[n][2 * hh], w1[n][2 * hh + 1]}, w2v = {w2[n][2 * hh], w2[n][2 * hh + 1]};
                          const f32x2 c = bbv + w2v * upv + w1v * u1v + w0v * u2v;
                          const f32x2 arg = c * ((c * c) * (-0.10294324f) + (-2.3022082f));
                          f32x2 ex; ex.x = __builtin_amdgcn_exp2f(arg.x); ex.y = __builtin_amdgcn_exp2f(arg.y);
                          const f32x2 d = ex + 1.0f; f32x2 rc; rc.x = __builtin_amdgcn_rcpf(d.x); rc.y = __builtin_amdgcn_rcpf(d.y);
                          const f32x2 a2 = (c * rc) * gtv; av[2 * hh] = a2.x; av[2 * hh + 1] = a2.y; } }
                    if (n == 0) { w.x = cvt_pk_bf16(av[0], av[1]); w.y = cvt_pk_bf16(av[2], av[3]); } else { w.z = cvt_pk_bf16(av[0], av[1]); w.w = cvt_pk_bf16(av[2], av[3]); } }
                *(u32x4*)(ACT + (size_t)(row0 + ai * HALF + m * 16) * 2816 + col0) = w; }
        }
    }
};

template <class Epi, class Sched, bool ALIGN_EPI = false, bool SP2 = false>
__device__ __forceinline__ void gemm_phase(PG8_LAS unsigned char* lds, const Gemm g, const Sched& S, const Epi& E) {
    const int tid = tid_now(), wid = __builtin_amdgcn_readfirstlane(tid >> 6), lane = tid & 63, wr = wid >> 2, wc = wid & 3, fr = lane & 15, fq = lane >> 4;
    const int K = g.K, nt = K / BK;
    unsigned voffA[2], voffB[2];
#pragma unroll
    for (int i = 0; i < 2; ++i) { int R, C; stage_rc(tid * 16 + i * 8192, R, C); const int Rb = Epi::PERM ? ((R & ~31) + perm32(R & 31)) : R;
        voffA[i] = (unsigned)(R * K + C) * 2u; voffB[i] = (unsigned)(Rb * K + C) * 2u; }
    const size_t kstep = (size_t)(BK * 2);
    const size_t hstep = (size_t)HALF * K * 2;
    const size_t tstep = 2 * hstep;
    const unsigned ldsw = (unsigned)wid * 1024u;
    const int aoff = lds_byte(wr * 64 + fr, fq * 8), boff = lds_byte(wc * 32 + fr, fq * 8);
#define PG8_SA(b, h) (((b) * 2 + (h)) * HTB)
#define PG8_SB(b, h) ((4 + (b) * 2 + (h)) * HTB)
#define PG8_STAGE(bufoff, gbase, voff) do { _Pragma("unroll") for (int _i = 0; _i < 2; ++_i) \
        __builtin_amdgcn_global_load_lds((const unsigned*)((const char*)(gbase) + (voff)[_i]), (PG8_LAS unsigned*)(lds + (bufoff) + ldsw + _i * 8192), 16, 0, 0); } while (0)
#define PG8_LDA(dst, b, h) do { _Pragma("unroll") for (int m = 0; m < 4; ++m) _Pragma("unroll") for (int k = 0; k < 2; ++k) dst[m][k] = *(const PG8_LAS bf16x8*)(lds + PG8_SA(b, h) + aoff + m * 2048 + k * 1024); } while (0)
#define PG8_LDB(dst, b, h) do { _Pragma("unroll") for (int n = 0; n < 2; ++n) _Pragma("unroll") for (int k = 0; k < 2; ++k) dst[n][k] = *(const PG8_LAS bf16x8*)(lds + PG8_SB(b, h) + boff + n * 2048 + k * 1024); } while (0)
#define PG8_MMA(ai, bj, At, Bt) do { __builtin_amdgcn_s_setprio(1); _Pragma("unroll") for (int m = 0; m < 4; ++m) _Pragma("unroll") for (int n = 0; n < 2; ++n) _Pragma("unroll") for (int k = 0; k < 2; ++k) \
        acc[ai][bj][m][n] = __builtin_amdgcn_mfma_f32_16x16x32_bf16(Bt[n][k], At[m][k], acc[ai][bj][m][n], 0, 0, 0); __builtin_amdgcn_s_setprio(0); } while (0)
#define PG8_WAIT_V(n) asm volatile("s_waitcnt vmcnt(" #n ")" ::: "memory")
#define PG8_WAIT_L(n) asm volatile("s_waitcnt lgkmcnt(" #n ")" ::: "memory")
#define PG8_BAR __builtin_amdgcn_s_barrier()
#define PG8_SCHED __builtin_amdgcn_sched_barrier(0)
    Unit cur, nxt; int ui = 0;
    if (!S.next(0, cur)) return;
    f32x4 acc[2][2][4][2];
#pragma unroll
    for (int a = 0; a < 2; ++a)
#pragma unroll
        for (int b = 0; b < 2; ++b)
#pragma unroll
            for (int m = 0; m < 4; ++m)
#pragma unroll
                for (int n = 0; n < 2; ++n) acc[a][b][m][n] = (f32x4){0.f, 0.f, 0.f, 0.f};
    bf16x8 At[4][2], B0[2][2], B1[2][2];
    const char* cA = (const char*)g.A + (size_t)cur.pm * tstep; const char* cB = (const char*)g.Bt + (size_t)cur.pn * tstep;
    S.a_ready(cur);
    if constexpr (SP2) {
        PG8_STAGE(PG8_SB(0, 0), cB, voffB); PG8_STAGE(PG8_SB(0, 1), cB + hstep, voffB); PG8_STAGE(PG8_SA(0, 0), cA, voffA); PG8_STAGE(PG8_SA(0, 1), cA + hstep, voffA);
        if (wr == 1) PG8_BAR;
        PG8_WAIT_V(2); PG8_BAR;
        PG8_STAGE(PG8_SB(1, 0), cB + kstep, voffB); PG8_STAGE(PG8_SA(1, 0), cA + kstep, voffA); PG8_STAGE(PG8_SB(1, 1), cB + hstep + kstep, voffB);
        PG8_WAIT_V(6); PG8_BAR;
    } else {
        PG8_STAGE(PG8_SB(0, 0), cB, voffB); PG8_STAGE(PG8_SA(0, 0), cA, voffA); PG8_STAGE(PG8_SB(0, 1), cB + hstep, voffB); PG8_STAGE(PG8_SA(0, 1), cA + hstep, voffA);
        if (wr == 1) PG8_BAR;
        PG8_WAIT_V(4); PG8_BAR;
        PG8_STAGE(PG8_SB(1, 0), cB + kstep, voffB); PG8_STAGE(PG8_SA(1, 0), cA + kstep, voffA); PG8_STAGE(PG8_SB(1, 1), cB + hstep + kstep, voffB);
        PG8_WAIT_V(6); PG8_BAR;
    }
    for (;;) {
        const bool has_next = S.next(ui + 1, nxt);
        const char* nA = has_next ? (const char*)g.A + (size_t)nxt.pm * tstep : cA; const char* nB = has_next ? (const char*)g.Bt + (size_t)nxt.pn * tstep : cB;
        for (int t = 0; t < nt; t += 2) {
            const bool last = (t == nt - 2);
            const char* a1 = cA + (size_t)(t + 1) * kstep;
            const char* a2 = last ? nA : cA + (size_t)(t + 2) * kstep; const char* b2 = last ? nB : cB + (size_t)(t + 2) * kstep;
            const char* a3 = a2 + kstep; const char* b3 = b2 + kstep;
            if (last && has_next) S.a_ready(nxt);
            if constexpr (SP2) {
            PG8_LDB(B0, 0, 0); PG8_LDB(B1, 0, 1); PG8_SCHED; PG8_LDA(At, 0, 0); PG8_STAGE(PG8_SA(1, 1), a1 + hstep, voffA);
            PG8_WAIT_V(8); PG8_WAIT_L(0); PG8_BAR; PG8_MMA(0, 0, At, B0); PG8_MMA(0, 1, At, B1); PG8_BAR; PG8_SCHED;
            PG8_LDA(At, 0, 1); PG8_STAGE(PG8_SB(0, 0), b2, voffB); PG8_STAGE(PG8_SB(0, 1), b2 + hstep, voffB); PG8_STAGE(PG8_SA(0, 0), a2, voffA);
            PG8_WAIT_V(8); PG8_WAIT_L(0); PG8_BAR; PG8_MMA(1, 0, At, B0); PG8_MMA(1, 1, At, B1); PG8_BAR; PG8_SCHED;
            PG8_LDB(B0, 1, 0); PG8_LDB(B1, 1, 1); PG8_SCHED; PG8_LDA(At, 1, 0); PG8_STAGE(PG8_SA(0, 1), a2 + hstep, voffA);
            PG8_WAIT_V(8); PG8_WAIT_L(0); PG8_BAR; PG8_MMA(0, 0, At, B0); PG8_MMA(0, 1, At, B1); PG8_BAR; PG8_SCHED;
            PG8_LDA(At, 1, 1); PG8_STAGE(PG8_SB(1, 0), b3, voffB); PG8_STAGE(PG8_SB(1, 1), b3 + hstep, voffB); PG8_STAGE(PG8_SA(1, 0), a3, voffA);
            PG8_WAIT_V(8); PG8_WAIT_L(0); PG8_BAR; PG8_MMA(1, 0, At, B0); PG8_MMA(1, 1, At, B1); PG8_BAR; PG8_SCHED;
            } else {
            PG8_LDB(B0, 0, 0); PG8_SCHED; PG8_LDA(At, 0, 0); PG8_STAGE(PG8_SA(1, 1), a1 + hstep, voffA);
            PG8_WAIT_L(8); PG8_BAR; PG8_WAIT_L(0); PG8_MMA(0, 0, At, B0); PG8_BAR; PG8_SCHED;
            PG8_LDB(B1, 0, 1); PG8_STAGE(PG8_SB(0, 0), b2, voffB);
            PG8_BAR; PG8_WAIT_L(0); PG8_MMA(0, 1, At, B1); PG8_BAR;
            PG8_LDA(At, 0, 1); PG8_STAGE(PG8_SA(0, 0), a2, voffA);
            PG8_BAR; PG8_WAIT_L(0); PG8_MMA(1, 0, At, B0); PG8_BAR; PG8_SCHED;
            PG8_STAGE(PG8_SB(0, 1), b2 + hstep, voffB);
            PG8_WAIT_V(6); PG8_BAR; PG8_MMA(1, 1, At, B1); PG8_BAR;
            PG8_LDB(B0, 1, 0); PG8_SCHED; PG8_LDA(At, 1, 0); PG8_STAGE(PG8_SA(0, 1), a2 + hstep, voffA);
            PG8_WAIT_L(8); PG8_BAR; PG8_WAIT_L(0); PG8_MMA(0, 0, At, B0); PG8_BAR; PG8_SCHED;
            PG8_LDB(B1, 1, 1); PG8_STAGE(PG8_SB(1, 0), b3, voffB);
            PG8_BAR; PG8_WAIT_L(0); PG8_MMA(0, 1, At, B1); PG8_BAR;
            PG8_LDA(At, 1, 1); PG8_STAGE(PG8_SA(1, 0), a3, voffA);
            PG8_BAR; PG8_WAIT_L(0); PG8_MMA(1, 0, At, B0); PG8_BAR; PG8_SCHED;
            PG8_STAGE(PG8_SB(1, 1), b3 + hstep, voffB);
            PG8_WAIT_V(6); PG8_BAR; PG8_MMA(1, 1, At, B1); PG8_BAR;
            }
        }
        if constexpr (ALIGN_EPI) { if (wr == 0) PG8_BAR; }
        if constexpr (!Epi::AFTER_DRAIN) { E(acc, cur, wr, wc, fr, fq); S.done(cur); }
        if (!has_next) break;
#pragma unroll
        for (int a = 0; a < 2; ++a)
#pragma unroll
            for (int b = 0; b < 2; ++b)
#pragma unroll
                for (int m = 0; m < 4; ++m)
#pragma unroll
                    for (int n = 0; n < 2; ++n) acc[a][b][m][n] = (f32x4){0.f, 0.f, 0.f, 0.f};
        cur = nxt; cA = nA; cB = nB; ++ui;
        if constexpr (ALIGN_EPI) { if (wr == 1) PG8_BAR; }
    }
    PG8_WAIT_V(0);
    if constexpr (!ALIGN_EPI) { if (wr == 0) PG8_BAR; }
    PG8_BAR;
    if constexpr (Epi::AFTER_DRAIN) { E.fused(acc, cur, wr, wc, fr, fq, lds, wid, lane); S.done(cur); }
#undef PG8_SA
#undef PG8_SB
#undef PG8_STAGE
#undef PG8_LDA
#undef PG8_LDB
#undef PG8_MMA
#undef PG8_WAIT_V
#undef PG8_WAIT_L
#undef PG8_BAR
#undef PG8_SCHED
}
}

#define LAS __attribute__((address_space(3)))
typedef unsigned short bf16_t;
typedef short bf16x8 __attribute__((ext_vector_type(8)));
typedef float f32x4 __attribute__((ext_vector_type(4)));
typedef float f32x2 __attribute__((ext_vector_type(2)));
typedef unsigned u32x4 __attribute__((ext_vector_type(4)));
typedef unsigned u32x2 __attribute__((ext_vector_type(2)));

constexpr int T_TOK = 32768, DM = 1024, SEQL = 8192, FFD = 2816, ZW = 2560;
constexpr size_t ZB = (size_t)T_TOK * 128;
constexpr int LDS_BYTES = 156 * 1024;
constexpr size_t OFF_SSQ = 0;
constexpr size_t OFF_BAR = 524288;
constexpr size_t OFF_W   = 540672;
constexpr size_t W_IN = 0, W_OUT = 2621440, W_UG = 3670016, W_DN = 9437184, W_LAYER = 12320768;
constexpr size_t OFF_XG  = OFF_W + 4 * W_LAYER * 2;
constexpr size_t OFF_U   = OFF_XG + (size_t)T_TOK * DM * 2;
constexpr size_t OFF_G   = OFF_U + (size_t)T_TOK * FFD * 2;
constexpr size_t OFF_Y   = OFF_G;
constexpr size_t OFF_ST  = OFF_G + (size_t)T_TOK * DM * 2;
constexpr size_t OFF_GL  = OFF_ST + 33554432;
constexpr size_t OFF_EU  = OFF_U + (size_t)T_TOK * ZW * 2;
constexpr size_t OFF_EG  = OFF_EU + (size_t)128 * 4 * FFD * 4;
constexpr size_t WS_END  = OFF_G + (size_t)T_TOK * FFD * 2;

struct Args { const float* in[25]; float* out; unsigned char* ws; int ph_lo, ph_hi; };
typedef const __attribute__((address_space(4))) Args* KA;

__device__ __forceinline__ float bf_lo(unsigned w) { return __uint_as_float(w << 16); }
__device__ __forceinline__ float bf_hi(unsigned w) { return __uint_as_float(w & 0xffff0000u); }
__device__ __forceinline__ unsigned pk2(float lo, float hi) { return pg8::cvt_pk_bf16(lo, hi); }
__device__ __forceinline__ unsigned short f2bf(float f) { return (unsigned short)(pk2(f, 0.f) & 0xffffu); }
__device__ __forceinline__ void unpack8(const u32x4 w, float (&f)[8]) {
    f[0] = bf_lo(w.x); f[1] = bf_hi(w.x); f[2] = bf_lo(w.y); f[3] = bf_hi(w.y); f[4] = bf_lo(w.z); f[5] = bf_hi(w.z); f[6] = bf_lo(w.w); f[7] = bf_hi(w.w); }
__device__ __forceinline__ u32x4 pack8(const float (&f)[8]) { u32x4 w; w.x = pk2(f[0], f[1]); w.y = pk2(f[2], f[3]); w.z = pk2(f[4], f[5]); w.w = pk2(f[6], f[7]); return w; }
__device__ __forceinline__ float sigmoidf_(float x) { return __builtin_amdgcn_rcpf(1.0f + __expf(-x)); }
__device__ __forceinline__ float gelu_tanh(float x) { const float u = 1.5957691216057308f * (x + 0.044715f * x * x * x); return x * __builtin_amdgcn_rcpf(1.0f + __expf(-u)); }
#define MFMA16(a, b, c) __builtin_amdgcn_mfma_f32_16x16x32_bf16((a), (b), (c), 0, 0, 0)

#define XB_TMO      128
#define XB_XCNT(j)  (256  + 64 * (j))
#define XB_XSUB(j)  (1280 + 64 * (j))
#define XB_XGEN(j)  (2304 + 64 * (j))
#define XB_TOP      3328
#define XB_TOPGEN   3392
#define XCD_BAR_WORDS 3456
#define XB_SPIN_CAP (1u << 18)

__device__ __forceinline__ unsigned xb_ld(unsigned* p)              { return __hip_atomic_load(p, __ATOMIC_RELAXED, __HIP_MEMORY_SCOPE_AGENT); }
__device__ __forceinline__ unsigned xb_add(unsigned* p, unsigned v) { return __hip_atomic_fetch_add(p, v, __ATOMIC_RELAXED, __HIP_MEMORY_SCOPE_AGENT); }
__device__ __forceinline__ unsigned xb_xcc_id() { return (unsigned)__builtin_amdgcn_s_getreg((3 << 11) | 20) & 0xFu; }
#define XB_SPIN(cond, bar) do { unsigned _sp = 0; while (cond) { __builtin_amdgcn_s_sleep(1); \
    if ((++_sp & 255u) == 0u) { if (xb_ld(&(bar)[XB_TMO])) break; if (_sp > XB_SPIN_CAP) { atomicAdd(&(bar)[XB_TMO], 1u); break; } } } } while (0)

struct XcdBarrier {
    unsigned* bar; unsigned x;
    volatile LAS unsigned* st;
};

__device__ __forceinline__ XcdBarrier xcd_barrier_post(unsigned* bar, volatile LAS unsigned* st) {
    XcdBarrier b; b.bar = bar; b.x = xb_xcc_id(); b.st = st;
    if (threadIdx.x == 0) (void)xb_add(&bar[XB_XCNT(b.x)], 1u);
    return b;
}
__device__ __forceinline__ void xcd_barrier_complete(unsigned* bar, unsigned x, unsigned& nloc, unsigned& nx) {
    const unsigned G = gridDim.x * gridDim.y * gridDim.z;
    unsigned sum, cnt, mine, sp = 0u;
    for (;;) {
        sum = 0u; cnt = 0u; mine = 0u;
#pragma unroll
        for (unsigned j = 0; j < 16; ++j) { const unsigned c = xb_ld(&bar[XB_XCNT(j)]); sum += c; cnt += (c > 0u) ? 1u : 0u; mine = (j == x) ? c : mine; }
        if (sum == G) break;
        __builtin_amdgcn_s_sleep(1);
        if ((++sp & 255u) == 0u) { if (xb_ld(&bar[XB_TMO])) break; if (sp > XB_SPIN_CAP) { atomicAdd(&bar[XB_TMO], 1u); break; } }
    }
    nloc = mine > 0u ? mine : 1u; nx = cnt > 0u ? cnt : 1u;
}

__device__ __forceinline__ void xcd_barrier(const XcdBarrier& b) {
    asm volatile("s_waitcnt vmcnt(0)" ::: "memory");
    __syncthreads();
    if (threadIdx.x == 0) {
        unsigned* bar = b.bar;
        __builtin_amdgcn_s_waitcnt(0);
        unsigned nloc = b.st[0], nx = b.st[1];
        if (nloc == 0u) { xcd_barrier_complete(bar, b.x, nloc, nx); b.st[0] = nloc; b.st[1] = nx; }
        const unsigned old = xb_add(&bar[XB_XSUB(b.x)], 1u);
        const unsigned gen = old / nloc;
        if (old + 1u == (gen + 1u) * nloc) {
            __builtin_amdgcn_fence(__ATOMIC_RELEASE, "agent");
            asm volatile("s_waitcnt vmcnt(0)" ::: "memory");
            const unsigned og = xb_add(&bar[XB_TOP], 1u);
            const unsigned tg = og / nx;
            if (og + 1u == (tg + 1u) * nx) xb_add(&bar[XB_TOPGEN], 1u);
            else XB_SPIN(xb_ld(&bar[XB_TOPGEN]) == tg, bar);
            __builtin_amdgcn_fence(__ATOMIC_ACQUIRE, "agent");
            xb_add(&bar[XB_XGEN(b.x)], 1u);
            asm volatile("s_waitcnt vmcnt(0)" ::: "memory");
        } else {
            XB_SPIN(xb_ld(&bar[XB_XGEN(b.x)]) == gen, bar);
            __builtin_amdgcn_fence(__ATOMIC_ACQUIRE, "agent");
            asm volatile("s_waitcnt vmcnt(0)" ::: "memory");
        }
    }
    __syncthreads();
}


struct TJob { const float* src; const float* gain; bf16_t* dst; int Nsrc, k0, n0, K, mode; };
__device__ __forceinline__ TJob tjob_decode(KA a, int job) {
    TJob J; const int l = job / 752; int j = job - l * 752; const int hl = l >> 1;
    bf16_t* Wl = (bf16_t*)(a->ws + OFF_W) + (size_t)l * W_LAYER;
    if (j < 160) { J.src = ((l & 1) ? a->in[14] : a->in[4]) + (size_t)hl * 1024 * 2560; J.Nsrc = 2560; J.k0 = (j / 10) * 64; J.n0 = (j % 10) * 256; J.dst = Wl + W_IN; J.K = 1024; J.mode = 0; J.gain = a->in[1] + (size_t)l * 1024; return J; }
    j -= 160;
    if (j < 64) { J.src = ((l & 1) ? a->in[15] : a->in[5]) + (size_t)hl * 1024 * 1024; J.Nsrc = 1024; J.k0 = (j / 4) * 64; J.n0 = (j % 4) * 256; J.dst = Wl + W_OUT; J.K = 1024; J.mode = 0; J.gain = nullptr; return J; }
    j -= 64;
    if (j < 352) { const int gate = j >= 176; if (gate) j -= 176; J.src = (gate ? a->in[21] : a->in[20]) + (size_t)l * 1024 * 2816; J.Nsrc = 2816; J.k0 = (j / 11) * 64; J.n0 = (j % 11) * 256; J.dst = Wl + W_UG; J.K = 1024; J.mode = 1 + gate; J.gain = a->in[2] + (size_t)l * 1024; return J; }
    j -= 352;
    J.src = a->in[24] + (size_t)l * 2816 * 1024; J.Nsrc = 1024; J.k0 = (j / 4) * 64; J.n0 = (j % 4) * 256; J.dst = Wl + W_DN; J.K = 2816; J.mode = 0; J.gain = nullptr; return J;
}
__device__ __forceinline__ void tjob_load(const TJob& J, int tid, f32x4 (&v)[4][2], float& g0, float& g1) {
    const int kk = tid >> 4, n4 = (tid & 15) * 4;
#pragma unroll
    for (int s = 0; s < 4; ++s)
#pragma unroll
        for (int p = 0; p < 2; ++p) v[s][p] = *(const f32x4*)(J.src + (size_t)(J.k0 + kk + 32 * p) * J.Nsrc + J.n0 + 64 * s + n4);
    g0 = 1.f; g1 = 1.f; if (J.gain) { g0 = J.gain[J.k0 + kk]; g1 = J.gain[J.k0 + kk + 32]; }
}
__device__ __forceinline__ void phase_prologue(KA a, LAS unsigned char* lds) {
    const int tid = tid_now(), G = gridDim.x, bx = blockIdx.x;
    float* ssq = (float*)(a->ws + OFF_SSQ);
    LAS unsigned short* tile = (LAS unsigned short*)lds;
    {
      constexpr int NJ = 4 * 752; int job = bx; f32x4 v[4][2]; float g0 = 1.f, g1 = 1.f; TJob J = tjob_decode(a, job < NJ ? job : 0);
      if (job < NJ) tjob_load(J, tid, v, g0, g1);
      const int kk = tid >> 4, n4 = (tid & 15) * 4, n = tid >> 3, k8 = (tid & 7) * 8;
      while (job < NJ) {
#pragma unroll
          for (int s = 0; s < 4; ++s)
#pragma unroll
              for (int p = 0; p < 2; ++p) { const f32x4 w = v[s][p] * (p ? g1 : g0); LAS unsigned short* tp = tile + s * 4608 + n4 * 72 + kk + 32 * p;
                  tp[0] = f2bf(w[0]); tp[72] = f2bf(w[1]); tp[144] = f2bf(w[2]); tp[216] = f2bf(w[3]); }
          bf16_t* const cdst = J.dst; const int cK = J.K, ck0 = J.k0, cn0 = J.n0, cmode = J.mode;
          const int nj = job + G;
          if (nj < NJ) { J = tjob_decode(a, nj); tjob_load(J, tid, v, g0, g1); }
          __syncthreads();
#pragma unroll
          for (int s = 0; s < 4; ++s) { const int nn = cn0 + 64 * s + n; const int drow = cmode ? ((nn >> 7) * 256 + (nn & 127) + (cmode - 1) * 128) : nn;
              *(u32x4*)(cdst + (size_t)drow * cK + ck0 + k8) = *(const LAS u32x4*)(tile + s * 4608 + n * 72 + k8); }
          __syncthreads();
          job = nj;
      }
    }
    const int lane = tid & 63, wave = tid >> 6;
    const float* x = a->in[0]; bf16_t* xg = (bf16_t*)(a->ws + OFF_XG);
    { const int STEP = G * 8 * 4; int row0 = bx * 8 + wave; f32x4 v[4][4];
#pragma unroll
      for (int rr = 0; rr < 4; ++rr)
#pragma unroll
          for (int i = 0; i < 4; ++i) { const int rw = (row0 + rr * G * 8 < T_TOK) ? row0 + rr * G * 8 : T_TOK - 1; v[rr][i] = *(const f32x4*)(x + (size_t)rw * 1024 + lane * 4 + 256 * i); }
      for (; row0 < T_TOK; row0 += STEP) {
        f32x4 vn[4][4]; const int nr0 = row0 + STEP;
#pragma unroll
        for (int rr = 0; rr < 4; ++rr)
#pragma unroll
            for (int i = 0; i < 4; ++i) { const int rw = (nr0 + rr * G * 8 < T_TOK) ? nr0 + rr * G * 8 : T_TOK - 1; vn[rr][i] = *(const f32x4*)(x + (size_t)rw * 1024 + lane * 4 + 256 * i); }
#pragma unroll
        for (int rr = 0; rr < 4; ++rr) { const int row = row0 + rr * G * 8; float s = 0.f; if (row >= T_TOK) continue;
#pragma unroll
            for (int i = 0; i < 4; ++i) { u32x2 w; w.x = pk2(v[rr][i][0], v[rr][i][1]); w.y = pk2(v[rr][i][2], v[rr][i][3]); *(u32x2*)(xg + (size_t)row * 1024 + lane * 4 + 256 * i) = w;
                const float y0 = bf_lo(w.x), y1 = bf_hi(w.x), y2 = bf_lo(w.y), y3 = bf_hi(w.y); s += (y0 * y0 + y1 * y1) + (y2 * y2 + y3 * y3); }
#pragma unroll
            for (int o = 32; o >= 1; o >>= 1) s += __shfl_xor(s, o);
            if (lane < 4) ssq[(size_t)row * 4 + lane] = (lane == 0) ? s : 0.f; }
#pragma unroll
        for (int rr = 0; rr < 4; ++rr)
#pragma unroll
            for (int i = 0; i < 4; ++i) v[rr][i] = vn[rr][i];
      } }
}

constexpr int LR_BB = 0, LR_AA = 34816, LR_XB = 69632, LR_WT = 88064, LR_XH = 106496, LR_SEG = 125440, LR_FOLD = 129536, LR_CW = 133632;
__device__ __forceinline__ void lru_load_xh(KA a, int unit, int tid, u32x4 (&pf)[3]) {
    const int h = unit & 7, c = (unit >> 3) & 63, b = unit >> 9; const bf16_t* Z = (const bf16_t*)(a->ws + OFF_U);
#pragma unroll
    for (int k = 0; k < 3; ++k) { const int idx = tid + 512 * k, r = idx >> 3, c8 = (idx & 7) * 8, pos = c * 128 - 3 + r;
        u32x4 w = {0u, 0u, 0u, 0u}; if (idx < 131 * 8 && pos >= 0) w = *(const u32x4*)(Z + (size_t)(h >> 1) * ZB + ((size_t)b * SEQL + pos) * 128 + (h & 1) * 64 + c8);
        pf[k] = w; }
}
__device__ __forceinline__ void lru_unit(KA a, LAS unsigned char* lds, int e, int unit, int pass, bool stage_w, u32x4 (&pf)[3], int next_unit) {
    const int tid = tid_now(), lane = tid & 63, wave = tid >> 6;
    const int h = unit & 7, c = (unit >> 3) & 63, b = unit >> 9;
    const bf16_t* Z = (const bf16_t*)(a->ws + OFF_U);
    f32x2* AGG = (f32x2*)(a->ws + OFF_ST);
    LAS float* BB = (LAS float*)(lds + LR_BB); LAS float* AA = (LAS float*)(lds + LR_AA);
    LAS unsigned short* XB = (LAS unsigned short*)(lds + LR_XB); LAS unsigned short* WT = (LAS unsigned short*)(lds + LR_WT);
    LAS unsigned short* XH = (LAS unsigned short*)(lds + LR_XH);
    LAS f32x2* SEG = (LAS f32x2*)(lds + LR_SEG); LAS f32x2* FOLD = (LAS f32x2*)(lds + LR_FOLD);
    const size_t tok0 = (size_t)b * SEQL + (size_t)c * 128;
    const int ch = tid & 63, seg = tid >> 6;
    const size_t aggbase = ((size_t)b * 64) * 512 + h * 64 + ch;
    f32x2 ag[8]; u32x4 gaw0 = {0u, 0u, 0u, 0u}, gaw1 = {0u, 0u, 0u, 0u};
    if (pass == 2) {
#pragma unroll
        for (int i = 0; i < 8; ++i) ag[i] = AGG[aggbase + (size_t)(seg * 8 + i) * 512];
        const bf16_t* gap = Z + (size_t)(4 + (h >> 1)) * ZB + (tok0 + (tid >> 2)) * 128 + (h & 1) * 64 + (tid & 3) * 16; gaw0 = *(const u32x4*)gap; gaw1 = *(const u32x4*)(gap + 8); }
    float wv[16]; float cv = 0.f;
    if (stage_w) { const float* wa = a->in[8] + (size_t)e * 32768 + h * 4096; const float* wi = a->in[10] + (size_t)e * 32768 + h * 4096;
#pragma unroll
      for (int k = 0; k < 16; ++k) { const int idx = tid + 512 * k; wv[k] = ((idx >> 12) ? wi : wa)[idx & 4095]; }
      const int grp = tid >> 6, cch = tid & 63;
      if (grp < 4) cv = a->in[6][(size_t)e * 2048 + grp * 512 + h * 64 + cch];
      else if (grp == 4) cv = a->in[7][(size_t)e * 512 + h * 64 + cch];
      else if (grp == 5) cv = a->in[9][(size_t)e * 512 + h * 64 + cch];
      else if (grp == 6) cv = a->in[11][(size_t)e * 512 + h * 64 + cch];
      else cv = a->in[12][(size_t)e * 512 + h * 64 + cch]; }
#pragma unroll
    for (int k = 0; k < 3; ++k) { const int idx = tid + 512 * k; if (idx < 131 * 8) *(LAS u32x4*)(XH + (idx >> 3) * 72 + (idx & 7) * 8) = pf[k]; }
    if (stage_w) {
#pragma unroll
      for (int k = 0; k < 16; ++k) { const int idx = tid + 512 * k, gate = idx >> 12, rem = idx & 4095, i = rem >> 6, j = rem & 63; WT[(gate * 64 + j) * 72 + i] = f2bf(wv[k]); }
      LAS float* CWs = (LAS float*)(lds + LR_CW);
      CWs[tid] = ((tid >> 6) == 7) ? __logf(1.0f + __expf(-cv)) : cv; }
    __syncthreads();
    { const int t = tid >> 2, c16 = (tid & 3) * 16;
      const LAS float* cw = (const LAS float*)(lds + LR_CW) + c16; const LAS float* cb = cw + 256;
      float xc[16];
#pragma unroll
      for (int i = 0; i < 4; ++i) { const f32x4 v = *(const LAS f32x4*)(cb + 4 * i); xc[4 * i] = v[0]; xc[4 * i + 1] = v[1]; xc[4 * i + 2] = v[2]; xc[4 * i + 3] = v[3]; }
#pragma unroll
      for (int j = 0; j < 4; ++j) {
          float xv[16]; { float t8[8]; unpack8(*(const LAS u32x4*)(XH + (t + j) * 72 + c16), t8);
#pragma unroll
              for (int i = 0; i < 8; ++i) xv[i] = t8[i];
              unpack8(*(const LAS u32x4*)(XH + (t + j) * 72 + c16 + 8), t8);
#pragma unroll
              for (int i = 0; i < 8; ++i) xv[8 + i] = t8[i]; }
#pragma unroll
          for (int i = 0; i < 4; ++i) { const f32x4 w = *(const LAS f32x4*)(cw + j * 64 + 4 * i);
              xc[4 * i] += w[0] * xv[4 * i]; xc[4 * i + 1] += w[1] * xv[4 * i + 1]; xc[4 * i + 2] += w[2] * xv[4 * i + 2]; xc[4 * i + 3] += w[3] * xv[4 * i + 3]; }
      }
#pragma unroll
      for (int i = 0; i < 4; ++i) *(LAS f32x4*)(BB + t * 68 + c16 + 4 * i) = (f32x4){xc[4 * i], xc[4 * i + 1], xc[4 * i + 2], xc[4 * i + 3]};
      u32x4 w0, w1; w0.x = pk2(xc[0], xc[1]); w0.y = pk2(xc[2], xc[3]); w0.z = pk2(xc[4], xc[5]); w0.w = pk2(xc[6], xc[7]);
      w1.x = pk2(xc[8], xc[9]); w1.y = pk2(xc[10], xc[11]); w1.z = pk2(xc[12], xc[13]); w1.w = pk2(xc[14], xc[15]);
      *(LAS u32x4*)(XB + t * 72 + c16) = w0; *(LAS u32x4*)(XB + t * 72 + c16 + 8) = w1; }
    __syncthreads();
    if (next_unit >= 0) lru_load_xh(a, next_unit, tid, pf);
    { const int r = lane & 15, q = lane >> 4, tb = wave;
      const bf16x8 a0 = *(const LAS bf16x8*)(XB + (tb * 16 + r) * 72 + q * 8), a1 = *(const LAS bf16x8*)(XB + (tb * 16 + r) * 72 + 32 + q * 8);
      const LAS float* ba = (const LAS float*)(lds + LR_CW) + 320; const LAS float* bi = ba + 64; const LAS float* spv = ba + 128;
#pragma unroll
      for (int cb = 0; cb < 4; ++cb) {
          const bf16x8 bA0 = *(const LAS bf16x8*)(WT + (cb * 16 + r) * 72 + q * 8), bA1 = *(const LAS bf16x8*)(WT + (cb * 16 + r) * 72 + 32 + q * 8);
          const bf16x8 bI0 = *(const LAS bf16x8*)(WT + (64 + cb * 16 + r) * 72 + q * 8), bI1 = *(const LAS bf16x8*)(WT + (64 + cb * 16 + r) * 72 + 32 + q * 8);
          f32x4 cA = {0.f, 0.f, 0.f, 0.f}, cI = {0.f, 0.f, 0.f, 0.f};
          cA = MFMA16(a0, bA0, cA); cA = MFMA16(a1, bA1, cA); cI = MFMA16(a0, bI0, cI); cI = MFMA16(a1, bI1, cI);
          const int ch = cb * 16 + r; const float bav = ba[ch], biv = bi[ch], sp = spv[ch];
#pragma unroll
          for (int j2 = 0; j2 < 2; ++j2) {
              const int t0 = tb * 16 + q * 4 + 2 * j2;
              const f32x2 xa = {cA[2 * j2] + bav, cA[2 * j2 + 1] + bav}, xi = {cI[2 * j2] + biv, cI[2 * j2 + 1] + biv};
              const f32x2 ea = xa * (-1.44269504f), ei = xi * (-1.44269504f);
              f32x2 da, di; da.x = 1.0f + __builtin_amdgcn_exp2f(ea.x); da.y = 1.0f + __builtin_amdgcn_exp2f(ea.y); di.x = 1.0f + __builtin_amdgcn_exp2f(ei.x); di.y = 1.0f + __builtin_amdgcn_exp2f(ei.y);
              f32x2 ra, ig; ra.x = __builtin_amdgcn_rcpf(da.x); ra.y = __builtin_amdgcn_rcpf(da.y); ig.x = __builtin_amdgcn_rcpf(di.x); ig.y = __builtin_amdgcn_rcpf(di.y);
              const f32x2 l2 = ra * (-8.0f * 1.44269504f * sp);
              f32x2 av; av.x = __builtin_amdgcn_exp2f(l2.x); av.y = __builtin_amdgcn_exp2f(l2.y);
              f32x2 om = 1.0f - av * av; om.x = fmaxf(om.x, 1e-30f); om.y = fmaxf(om.y, 1e-30f);
              f32x2 rq; rq.x = __builtin_amdgcn_rsqf(om.x); rq.y = __builtin_amdgcn_rsqf(om.y);
              f32x2 mult = om * rq;
              if (c == 0 && t0 == 0) mult.x = 1.0f;
              const f32x2 xcv = {BB[t0 * 68 + ch], BB[(t0 + 1) * 68 + ch]};
              const f32x2 bv = (mult * ig) * xcv;
              AA[t0 * 68 + ch] = av.x; AA[(t0 + 1) * 68 + ch] = av.y; BB[t0 * 68 + ch] = bv.x; BB[(t0 + 1) * 68 + ch] = bv.y; }
      } }
    __syncthreads();
    { float hh = 0.f, P = 1.f;
#pragma unroll
      for (int i = 0; i < 16; ++i) { const int t = seg * 16 + i; const float av = AA[t * 68 + ch], bv = BB[t * 68 + ch]; hh = av * hh + bv; P *= av; BB[t * 68 + ch] = hh; AA[t * 68 + ch] = P; }
      SEG[seg * 64 + ch] = (f32x2){P, hh}; }
    if (pass == 1) {
        __syncthreads();
        if (tid < 64) { float P = 1.f, hh = 0.f;
#pragma unroll
            for (int s = 0; s < 8; ++s) { const f32x2 sg = SEG[s * 64 + ch]; hh = sg.x * hh + sg.y; P *= sg.x; }
            AGG[aggbase + (size_t)c * 512] = (f32x2){P, hh}; }
        __syncthreads();
        return;
    }
    { float P = 1.f, hh = 0.f;
#pragma unroll
      for (int i = 0; i < 8; ++i) { const int cc = seg * 8 + i; const bool use = cc < c; const float p = use ? ag[i].x : 1.f, q = use ? ag[i].y : 0.f; hh = p * hh + q; P *= p; }
      FOLD[seg * 64 + ch] = (f32x2){P, hh}; }
    __syncthreads();
    { float hin = 0.f;
#pragma unroll
      for (int s = 0; s < 8; ++s) { const f32x2 f = FOLD[s * 64 + ch]; hin = f.x * hin + f.y; }
#pragma unroll
      for (int s = 0; s < 8; ++s) { if (s < seg) { const f32x2 sg = SEG[s * 64 + ch]; hin = sg.x * hin + sg.y; } }
#pragma unroll
      for (int i = 0; i < 16; ++i) { const int t = seg * 16 + i; BB[t * 68 + ch] += AA[t * 68 + ch] * hin; } }
    __syncthreads();
    { const int t = tid >> 2, c16 = (tid & 3) * 16; bf16_t* Y = (bf16_t*)(a->ws + OFF_Y);
      float g0[8], g1[8]; unpack8(gaw0, g0); unpack8(gaw1, g1);
      float y0[8], y1[8];
#pragma unroll
      for (int i4 = 0; i4 < 2; ++i4) { const f32x4 hA = *(const LAS f32x4*)(BB + t * 68 + c16 + 4 * i4), hB = *(const LAS f32x4*)(BB + t * 68 + c16 + 8 + 4 * i4);
#pragma unroll
          for (int j = 0; j < 4; ++j) { y0[4 * i4 + j] = hA[j] * gelu_tanh(g0[4 * i4 + j]); y1[4 * i4 + j] = hB[j] * gelu_tanh(g1[4 * i4 + j]); } }
      bf16_t* yp = Y + (tok0 + t) * 1024 + h * 64 + c16;
      *(u32x4*)yp = pack8(y0); *(u32x4*)(yp + 8) = pack8(y1); }
    __syncthreads();
}
__device__ __forceinline__ void sconv_unit(KA a, int e, int unit) {
    const int tid = tid_now(), c8 = (tid & 63) * 8, tt = tid >> 6;
    const bf16_t* Z = (const bf16_t*)(a->ws + OFF_U); bf16_t* Y = (bf16_t*)(a->ws + OFF_Y);
    const float* sw = a->in[13] + (size_t)e * 1536 + c8;
    float w[3][8];
#pragma unroll
    for (int j = 0; j < 3; ++j) { const f32x4 v0 = *(const f32x4*)(sw + j * 512), v1 = *(const f32x4*)(sw + j * 512 + 4);
        w[j][0] = v0[0]; w[j][1] = v0[1]; w[j][2] = v0[2]; w[j][3] = v0[3]; w[j][4] = v1[0]; w[j][5] = v1[1]; w[j][6] = v1[2]; w[j][7] = v1[3]; }
    const bf16_t* zb = Z + (size_t)(c8 >> 7) * ZB + (c8 & 127);
    u32x4 hbw[4][3], cgw[4][3], bgw[4];
#pragma unroll
    for (int rr = 0; rr < 4; ++rr) { const int tok = unit * 32 + rr * 8 + tt, pos = tok & (SEQL - 1);
#pragma unroll
        for (int j = 0; j < 3; ++j) { const int d = 2 - j; const bf16_t* zr = zb + (size_t)((pos >= d) ? tok - d : tok) * 128;
            hbw[rr][j] = *(const u32x4*)(zr + 8 * ZB); cgw[rr][j] = *(const u32x4*)(zr + 16 * ZB); }
        bgw[rr] = *(const u32x4*)(zb + 12 * ZB + (size_t)tok * 128); }
#pragma unroll
    for (int rr = 0; rr < 4; ++rr) { const int tok = unit * 32 + rr * 8 + tt, pos = tok & (SEQL - 1);
        float acc[8];
#pragma unroll
        for (int i = 0; i < 8; ++i) acc[i] = 0.f;
#pragma unroll
        for (int j = 0; j < 3; ++j) { const float msk = (pos >= 2 - j) ? 1.0f : 0.0f; float hb[8], cgv[8]; unpack8(hbw[rr][j], hb); unpack8(cgw[rr][j], cgv);
#pragma unroll
            for (int i = 0; i < 8; ++i) acc[i] += (w[j][i] * msk) * (cgv[i] * hb[i]); }
        float bg[8]; unpack8(bgw[rr], bg);
#pragma unroll
        for (int i = 0; i < 8; ++i) acc[i] *= bg[i];
        *(u32x4*)(Y + (size_t)tok * 1024 + 512 + c8) = pack8(acc);
    }
}

constexpr int PL_UH = 0, PL_PA = 38912, PL_WT = 73728;
__device__ __forceinline__ void pool_load_uh(KA a, int unit, int tid, u32x4 (&pf)[5]) {
    const int g = unit & 3, tile = unit >> 2; const int tok0 = tile * 128, pos0 = tok0 & (SEQL - 1); const bf16_t* Z = (const bf16_t*)(a->ws + OFF_U);
#pragma unroll
    for (int k = 0; k < 5; ++k) { const int idx = tid + 512 * k, r = idx >> 4, c8 = (idx & 15) * 8, pos = pos0 - 15 + r;
        u32x4 w = {0u, 0u, 0u, 0u}; if (idx < 143 * 16 && pos >= 0) w = *(const u32x4*)(Z + (size_t)g * ZB + (size_t)(tok0 - 15 + r) * 128 + c8);
        pf[k] = w; }
}
__device__ __forceinline__ void pool_unit(KA a, LAS unsigned char* lds, int o, int unit, bool stage_w, u32x4 (&pf)[5], int next_unit) {
    const int tid = tid_now(), lane = tid & 63, wave = tid >> 6;
    const int g = unit & 3, tile = unit >> 2; const int tok0 = tile * 128, pos0 = tok0 & (SEQL - 1);
    const bf16_t* Z = (const bf16_t*)(a->ws + OFF_U); bf16_t* Y = (bf16_t*)(a->ws + OFF_Y);
    LAS unsigned short* UH = (LAS unsigned short*)(lds + PL_UH); LAS unsigned short* PA = (LAS unsigned short*)(lds + PL_PA); LAS unsigned short* WT = (LAS unsigned short*)(lds + PL_WT);
#pragma unroll
    for (int k = 0; k < 5; ++k) { const int idx = tid + 512 * k; if (idx < 143 * 16) *(LAS u32x4*)(UH + (idx >> 4) * 136 + (idx & 15) * 8) = pf[k]; }
    if (stage_w) { const float* pw = a->in[16] + (size_t)o * 65536 + g * 16384;
#pragma unroll
      for (int kb = 0; kb < 2; ++kb) { float wv[16];
#pragma unroll
          for (int k = 0; k < 16; ++k) wv[k] = pw[tid + 512 * (kb * 16 + k)];
#pragma unroll
          for (int k = 0; k < 16; ++k) { const int idx = tid + 512 * (kb * 16 + k), i = idx >> 7, oo = idx & 127; WT[oo * 136 + i] = f2bf(wv[k]); } } }
    __syncthreads();
    {
      const int c8 = (tid & 15) * 8, tg = (tid >> 4) * 4; const int win = 2 << g;
      float s[8];
#pragma unroll
      for (int i = 0; i < 8; ++i) s[i] = 0.f;
      for (int k = 0; k < win; ++k) { float v[8]; unpack8(*(const LAS u32x4*)(UH + (tg + 15 - k) * 136 + c8), v);
#pragma unroll
          for (int i = 0; i < 8; ++i) s[i] += v[i]; }
#pragma unroll
      for (int tt = 0; tt < 4; ++tt) { const int t = tg + tt; float u0[8]; unpack8(*(const LAS u32x4*)(UH + (t + 15) * 136 + c8), u0);
          if (tt > 0) { float ul[8]; unpack8(*(const LAS u32x4*)(UH + (t + 15 - win) * 136 + c8), ul);
#pragma unroll
              for (int i = 0; i < 8; ++i) s[i] += u0[i] - ul[i]; }
          const int pos = pos0 + t; const int n = (pos + 1 < win) ? pos + 1 : win; const float inv = __builtin_amdgcn_rcpf((float)n);
          float p[8];
#pragma unroll
          for (int i = 0; i < 8; ++i) p[i] = s[i] * inv - u0[i];
          *(LAS u32x4*)(PA + t * 136 + c8) = pack8(p); } }
    __syncthreads();
    if (next_unit >= 0) pool_load_uh(a, next_unit, tid, pf);
    { const int r = lane & 15, q = lane >> 4, tb = wave;
      bf16x8 af[4];
#pragma unroll
      for (int ks = 0; ks < 4; ++ks) af[ks] = *(const LAS bf16x8*)(PA + (tb * 16 + r) * 136 + ks * 32 + q * 8);
      const float* sc = a->in[17] + (size_t)o * 512 + g * 128;
#pragma unroll
      for (int ob = 0; ob < 8; ++ob) { f32x4 cc = {0.f, 0.f, 0.f, 0.f};
#pragma unroll
          for (int ks = 0; ks < 4; ++ks) cc = MFMA16(af[ks], *(const LAS bf16x8*)(WT + (ob * 16 + r) * 136 + ks * 32 + q * 8), cc);
          const float s = sc[ob * 16 + r];
#pragma unroll
          for (int jj = 0; jj < 4; ++jj) PA[(tb * 16 + q * 4 + jj) * 136 + ob * 16 + r] = f2bf(cc[jj] * s); }
      { const int rr = lane >> 2, c32 = (lane & 3) * 32;
#pragma unroll
        for (int k = 0; k < 4; ++k) *(u32x4*)(Y + (size_t)(tok0 + tb * 16 + rr) * 1024 + g * 128 + c32 + 8 * k) = *(const LAS u32x4*)(PA + (tb * 16 + rr) * 136 + c32 + 8 * k); } }
    __syncthreads();
}

constexpr int HG_QT = 0, HG_KT = 17408, HG_QP = 34816, HG_KTT = 52224, HG_VT = 70656, HG_AM = 89088, HG_SB = 98304, HG_DL = 133120, HG_EL = 133632, HG_LB = 134144, HG_GLS = 134656, HG_NG = 135168;
__device__ __forceinline__ float wave_scan_incl(float x) {
    x += __int_as_float(__builtin_amdgcn_update_dpp(0, __float_as_int(x), 0x111, 0xf, 0xf, true));
    x += __int_as_float(__builtin_amdgcn_update_dpp(0, __float_as_int(x), 0x112, 0xf, 0xf, true));
    x += __int_as_float(__builtin_amdgcn_update_dpp(0, __float_as_int(x), 0x114, 0xf, 0xf, true));
    x += __int_as_float(__builtin_amdgcn_update_dpp(0, __float_as_int(x), 0x118, 0xf, 0xf, true));
    x += __int_as_float(__builtin_amdgcn_update_dpp(0, __float_as_int(x), 0x142, 0xa, 0xf, false));
    x += __int_as_float(__builtin_amdgcn_update_dpp(0, __float_as_int(x), 0x143, 0xc, 0xf, false));
    return x;
}
__device__ __forceinline__ void hgrn_load_first(KA a, int unit, int tid, int pass, u32x4 (&nx)[6]) {
    const int lane = tid & 63, wave = tid >> 6, h = unit & 3, blk = (unit >> 2) & 31, b = unit >> 7;
    const bf16_t* zl = (const bf16_t*)(a->ws + OFF_U) + (size_t)h * ZB + ((size_t)b * SEQL + blk * 256 + lane) * 128 + wave * 16;
    nx[0] = *(const u32x4*)(zl + 8 * ZB); nx[1] = *(const u32x4*)(zl + 8 * ZB + 8); nx[2] = *(const u32x4*)(zl + 12 * ZB); nx[3] = *(const u32x4*)(zl + 12 * ZB + 8);
    if (pass == 2) { nx[4] = *(const u32x4*)(zl + 4 * ZB); nx[5] = *(const u32x4*)(zl + 4 * ZB + 8); } else { nx[4] = (u32x4){0u, 0u, 0u, 0u}; nx[5] = (u32x4){0u, 0u, 0u, 0u}; }
}
__device__ __forceinline__ void hgrn_unit(KA a, LAS unsigned char* lds, int o, int unit, int pass, u32x4 (&nx)[6], int next_unit) {
    const int tid = tid_now(), lane = tid & 63, wave = tid >> 6, r = lane & 15, q = lane >> 4;
    const int h = unit & 3, blk = (unit >> 2) & 31, b = unit >> 7;
    const bf16_t* Z = (const bf16_t*)(a->ws + OFF_U); bf16_t* Y = (bf16_t*)(a->ws + OFF_Y);
    float* DS = (float*)(a->ws + OFF_ST) + ((size_t)((b * 32 + blk) * 4 + h)) * 16384;
    float* GLB = (float*)(a->ws + OFF_GL) + ((size_t)((b * 32 + blk) * 4 + h)) * 128;
    LAS float* Os = (LAS float*)(lds + HG_QT);
    LAS unsigned short* QT = (LAS unsigned short*)(lds + HG_QT); LAS unsigned short* KT = (LAS unsigned short*)(lds + HG_KT); LAS unsigned short* QP = (LAS unsigned short*)(lds + HG_QP);
    LAS unsigned short* KTT = (LAS unsigned short*)(lds + HG_KTT); LAS unsigned short* VT = (LAS unsigned short*)(lds + HG_VT);
    LAS unsigned short* AM = (LAS unsigned short*)(lds + HG_AM); LAS unsigned short* SB = (LAS unsigned short*)(lds + HG_SB);
    LAS float* DL = (LAS float*)(lds + HG_DL); LAS float* EL = (LAS float*)(lds + HG_EL); LAS float* LBS = (LAS float*)(lds + HG_LB); LAS float* GLS = (LAS float*)(lds + HG_GLS); LAS float* NGS = (LAS float*)(lds + HG_NG);
    const int t = tid >> 3, d0 = (tid & 7) * 16;
    if (tid < 128) { float v = 0.f; if (o == 1) { const float l0 = a->in[18][h * 128 + tid], l1 = a->in[18][512 + h * 128 + tid]; v = 1.0f / (1.0f + __expf(l0 - l1)); } LBS[tid] = 1.0f - v; GLS[tid] = 0.f; NGS[tid] = a->in[19][(size_t)o * 512 + h * 128 + tid]; }
    __syncthreads();
    f32x4 St[8];
#pragma unroll
    for (int kb = 0; kb < 8; ++kb) { if (pass == 2) {
#pragma unroll
            for (int jj = 0; jj < 4; ++jj) St[kb][jj] = DS[(wave * 16 + q * 4 + jj) * 128 + kb * 16 + r]; } else St[kb] = (f32x4){0.f, 0.f, 0.f, 0.f}; }
    const bf16_t* zl = Z + (size_t)h * ZB + ((size_t)b * SEQL + blk * 256 + lane) * 128 + wave * 16;
    u32x4 nfw0 = nx[0], nfw1 = nx[1], nvw0 = nx[2], nvw1 = nx[3], nqw0 = nx[4], nqw1 = nx[5];
    const int tsw = (((lane >> 3) ^ wave) << 3) + (lane & 7);
    for (int s = 0; s < 4; ++s) {
        const size_t row = (size_t)b * SEQL + blk * 256 + s * 64 + t;
        const u32x4 fw0 = nfw0, fw1 = nfw1, qw0 = nqw0, qw1 = nqw1, vw0 = nvw0, vw1 = nvw1;
        if (s < 3) { const bf16_t* zn = zl + (size_t)(s + 1) * 64 * 128;
            nfw0 = *(const u32x4*)(zn + 8 * ZB); nfw1 = *(const u32x4*)(zn + 8 * ZB + 8); nvw0 = *(const u32x4*)(zn + 12 * ZB); nvw1 = *(const u32x4*)(zn + 12 * ZB + 8);
            if (pass == 2) { nqw0 = *(const u32x4*)(zn + 4 * ZB); nqw1 = *(const u32x4*)(zn + 4 * ZB + 8); } }
        else if (next_unit >= 0) hgrn_load_first(a, next_unit, tid, pass, nx);
#pragma unroll
        for (int hv = 0; hv < 2; ++hv) { const int dd = wave * 16 + hv * 8;
            float fz[8], qq[8], vv[8], qt[8], kt[8], qp[8]; unpack8(hv ? fw1 : fw0, fz); unpack8(hv ? qw1 : qw0, qq); unpack8(hv ? vw1 : vw0, vv);
            float glv = 0.f, grv = 0.f;
#pragma unroll
            for (int i = 0; i < 8; i += 2) {
                const f32x2 lbv = *(const LAS f32x2*)(LBS + dd + i);
                const f32x2 e2 = (f32x2){fz[i], fz[i + 1]} * 1.44269504f;
                f32x2 dn; dn.x = 1.0f + __builtin_amdgcn_exp2f(e2.x); dn.y = 1.0f + __builtin_amdgcn_exp2f(e2.y);
                f32x2 rc; rc.x = __builtin_amdgcn_rcpf(dn.x); rc.y = __builtin_amdgcn_rcpf(dn.y);
                const f32x2 kk = lbv * rc;
                f32x2 om = 1.0f - kk; om.x = fmaxf(om.x, 1e-20f); om.y = fmaxf(om.y, 1e-20f);
                f32x2 g2; g2.x = wave_scan_incl(__builtin_amdgcn_logf(om.x)); g2.y = wave_scan_incl(__builtin_amdgcn_logf(om.y));
                f32x2 gr, gl2; gr.x = __int_as_float(__builtin_amdgcn_readlane(__float_as_int(g2.x), 31)); gr.y = __int_as_float(__builtin_amdgcn_readlane(__float_as_int(g2.y), 31));
                gl2.x = __int_as_float(__builtin_amdgcn_readlane(__float_as_int(g2.x), 63)); gl2.y = __int_as_float(__builtin_amdgcn_readlane(__float_as_int(g2.y), 63));
                f32x2 a1 = g2 - gr, a2 = gr - g2; a1.x = fminf(a1.x, 115.f); a1.y = fminf(a1.y, 115.f); a2.x = fminf(a2.x, 115.f); a2.y = fminf(a2.y, 115.f);
                f32x2 E0, E1, E2; E0.x = __builtin_amdgcn_exp2f(g2.x); E0.y = __builtin_amdgcn_exp2f(g2.y); E1.x = __builtin_amdgcn_exp2f(a1.x); E1.y = __builtin_amdgcn_exp2f(a1.y); E2.x = __builtin_amdgcn_exp2f(a2.x); E2.y = __builtin_amdgcn_exp2f(a2.y);
                const f32x2 qv = {qq[i], qq[i + 1]}; const f32x2 qpv = qv * E0, qtv = qv * E1, ktv = kk * E2;
                qp[i] = qpv.x; qp[i + 1] = qpv.y; qt[i] = qtv.x; qt[i + 1] = qtv.y; kt[i] = ktv.x; kt[i + 1] = ktv.y;
                glv = (lane == i) ? gl2.x : glv; grv = (lane == i) ? gr.x : grv; glv = (lane == i + 1) ? gl2.y : glv; grv = (lane == i + 1) ? gr.y : grv;
                KTT[(dd + i) * 72 + tsw] = f2bf(kt[i]); VT[(dd + i) * 72 + tsw] = f2bf(vv[i]); KTT[(dd + i + 1) * 72 + tsw] = f2bf(kt[i + 1]); VT[(dd + i + 1) * 72 + tsw] = f2bf(vv[i + 1]); }
            if (lane < 8) { DL[dd + lane] = __builtin_amdgcn_exp2f(glv); EL[dd + lane] = __builtin_amdgcn_exp2f(glv - grv); GLS[dd + lane] += glv * 0.69314718f; }
            if (pass == 2) { *(LAS u32x4*)(QT + lane * 136 + dd) = pack8(qt); *(LAS u32x4*)(KT + lane * 136 + dd) = pack8(kt); *(LAS u32x4*)(QP + lane * 136 + dd) = pack8(qp); } }
        if (pass == 2) {
#pragma unroll
            for (int kb = 0; kb < 8; ++kb)
#pragma unroll
                for (int jj = 0; jj < 4; ++jj) SB[(wave * 16 + q * 4 + jj) * 136 + kb * 16 + r] = f2bf(St[kb][jj]); }
        __syncthreads();
        u32x4 gdw0 = {0u, 0u, 0u, 0u}, gdw1 = {0u, 0u, 0u, 0u};
        if (pass == 2) { const bf16_t* zg = Z + (size_t)h * ZB + row * 128 + d0 + 16 * ZB; gdw0 = *(const u32x4*)zg; gdw1 = *(const u32x4*)(zg + 8); }
        f32x4 oacc[4];
        const int ib = wave >> 1, vb0 = (wave & 1) * 4;
        if (pass == 2) {
#pragma unroll
            for (int tt = 0; tt < 2; ++tt) { const int tile = wave * 2 + tt, ia = tile >> 2, jb = tile & 3; f32x4 cc = {0.f, 0.f, 0.f, 0.f};
                if (jb <= ia) {
#pragma unroll
                    for (int ks = 0; ks < 4; ++ks) cc = MFMA16(*(const LAS bf16x8*)(QT + (ia * 16 + r) * 136 + ks * 32 + q * 8), *(const LAS bf16x8*)(KT + (jb * 16 + r) * 136 + ks * 32 + q * 8), cc); }
#pragma unroll
                for (int jj = 0; jj < 4; ++jj) { const int i = ia * 16 + q * 4 + jj, j = jb * 16 + r; AM[i * 72 + j] = f2bf((jb <= ia && j <= i) ? cc[jj] : 0.f); } }
            bf16x8 qa[4];
#pragma unroll
            for (int ks = 0; ks < 4; ++ks) qa[ks] = *(const LAS bf16x8*)(QP + (ib * 16 + r) * 136 + ks * 32 + q * 8);
#pragma unroll
            for (int vi = 0; vi < 4; ++vi) { f32x4 cc = {0.f, 0.f, 0.f, 0.f};
#pragma unroll
                for (int ks = 0; ks < 4; ++ks) cc = MFMA16(qa[ks], *(const LAS bf16x8*)(SB + ((vb0 + vi) * 16 + r) * 136 + ks * 32 + q * 8), cc);
                oacc[vi] = cc; }
            __syncthreads();
            const bf16x8 am0 = *(const LAS bf16x8*)(AM + (ib * 16 + r) * 72 + q * 8), am1 = *(const LAS bf16x8*)(AM + (ib * 16 + r) * 72 + 32 + q * 8);
#pragma unroll
            for (int vi = 0; vi < 4; ++vi) { oacc[vi] = MFMA16(am0, *(const LAS bf16x8*)(VT + ((vb0 + vi) * 16 + r) * 72 + ((q ^ (vb0 + vi)) << 3)), oacc[vi]);
                oacc[vi] = MFMA16(am1, *(const LAS bf16x8*)(VT + ((vb0 + vi) * 16 + r) * 72 + (((4 + q) ^ (vb0 + vi)) << 3)), oacc[vi]); }
        }
        { const bf16x8 va0 = *(const LAS bf16x8*)(VT + (wave * 16 + r) * 72 + ((q ^ wave) << 3)), va1 = *(const LAS bf16x8*)(VT + (wave * 16 + r) * 72 + (((4 + q) ^ wave) << 3));
#pragma unroll
          for (int kb = 0; kb < 8; ++kb) { f32x4 cc = {0.f, 0.f, 0.f, 0.f};
              cc = MFMA16(va0, *(const LAS bf16x8*)(KTT + (kb * 16 + r) * 72 + ((q ^ kb) << 3)), cc); cc = MFMA16(va1, *(const LAS bf16x8*)(KTT + (kb * 16 + r) * 72 + (((4 + q) ^ kb) << 3)), cc);
              const float dl = DL[kb * 16 + r], el = EL[kb * 16 + r]; St[kb] = St[kb] * dl + cc * el; } }
        if (pass == 2) {
#pragma unroll
            for (int vi = 0; vi < 4; ++vi)
#pragma unroll
                for (int jj = 0; jj < 4; ++jj) Os[(ib * 16 + q * 4 + jj) * 132 + (vb0 + vi) * 16 + r] = oacc[vi][jj];
            __syncthreads();
            float ov[16]; float ss = 0.f;
#pragma unroll
            for (int i = 0; i < 4; ++i) { const f32x4 v = *(const LAS f32x4*)(Os + t * 132 + d0 + 4 * i); ov[4 * i] = v[0]; ov[4 * i + 1] = v[1]; ov[4 * i + 2] = v[2]; ov[4 * i + 3] = v[3];
                ss += (v[0] * v[0] + v[1] * v[1]) + (v[2] * v[2] + v[3] * v[3]); }
            ss += __shfl_xor(ss, 1); ss += __shfl_xor(ss, 2); ss += __shfl_xor(ss, 4);
            const float rstd = __builtin_amdgcn_rsqf(ss * (1.0f / 128.0f) + 1e-6f);
            float gd0[8], gd1[8]; unpack8(gdw0, gd0); unpack8(gdw1, gd1);
            const LAS float* ng = NGS + d0;
            float y0[8], y1[8];
#pragma unroll
            for (int i = 0; i < 8; ++i) { y0[i] = ov[i] * rstd * ng[i] * (gd0[i] * sigmoidf_(gd0[i])); y1[i] = ov[8 + i] * rstd * ng[8 + i] * (gd1[i] * sigmoidf_(gd1[i])); }
            bf16_t* yp = Y + row * 1024 + 512 + h * 128 + d0;
            *(u32x4*)yp = pack8(y0); *(u32x4*)(yp + 8) = pack8(y1);
        }
        __syncthreads();
    }
    if (pass == 1) {
#pragma unroll
        for (int kb = 0; kb < 8; ++kb)
#pragma unroll
            for (int jj = 0; jj < 4; ++jj) DS[(wave * 16 + q * 4 + jj) * 128 + kb * 16 + r] = St[kb][jj];
        if (tid < 128) GLB[tid] = GLS[tid];
    }
    __syncthreads();
}
__device__ __forceinline__ void hgrn_scan(KA a) {
    const int G = gridDim.x;
    for (int item = blockIdx.x * 512 + tid_now(); item < 16 * 8192; item += G * 512) {
        const int bh = item >> 13, e2 = item & 8191, bb = bh >> 2, h = bh & 3, k2 = (e2 & 63) * 2;
        f32x2* ds = (f32x2*)((float*)(a->ws + OFF_ST) + ((size_t)(bb * 32 * 4 + h)) * 16384) + e2;
        const f32x2* gl = (const f32x2*)((const float*)(a->ws + OFF_GL) + ((size_t)(bb * 32 * 4 + h)) * 128 + k2);
        f32x2 run = {0.f, 0.f};
#pragma unroll 16
        for (int blk = 0; blk < 32; ++blk) { const f32x2 tmp = ds[(size_t)blk * 4 * 8192]; const f32x2 g = gl[(size_t)blk * 4 * 64];
            ds[(size_t)blk * 4 * 8192] = run; run.x = __expf(g.x) * run.x + tmp.x; run.y = __expf(g.y) * run.y + tmp.y; }
    }
}

__device__ __forceinline__ void phase_act(KA a, int l) {
    const bf16_t* U = (const bf16_t*)(a->ws + OFF_U); bf16_t* Gt = (bf16_t*)(a->ws + OFF_G);
    const float* cw = a->in[22] + (size_t)l * 3 * FFD; const float* cb = a->in[23] + (size_t)l * FFD;
    const int G = gridDim.x;
    for (int item = blockIdx.x * 512 + tid_now(); item < T_TOK * 352; item += G * 512) {
        const int tok = item / 352, c8 = (item - tok * 352) * 8, pos = tok & (SEQL - 1);
        float acc[8]; { const f32x4 b0 = *(const f32x4*)(cb + c8), b1 = *(const f32x4*)(cb + c8 + 4); acc[0] = b0[0]; acc[1] = b0[1]; acc[2] = b0[2]; acc[3] = b0[3]; acc[4] = b1[0]; acc[5] = b1[1]; acc[6] = b1[2]; acc[7] = b1[3]; }
#pragma unroll
        for (int j = 0; j < 3; ++j) { const int d = 2 - j;
            if (pos >= d) { float u[8]; unpack8(*(const u32x4*)(U + (size_t)(tok - d) * FFD + c8), u);
                const f32x4 w0 = *(const f32x4*)(cw + j * FFD + c8), w1 = *(const f32x4*)(cw + j * FFD + c8 + 4);
                acc[0] += w0[0] * u[0]; acc[1] += w0[1] * u[1]; acc[2] += w0[2] * u[2]; acc[3] += w0[3] * u[3]; acc[4] += w1[0] * u[4]; acc[5] += w1[1] * u[5]; acc[6] += w1[2] * u[6]; acc[7] += w1[3] * u[7]; } }
        float gt[8]; unpack8(*(const u32x4*)(Gt + (size_t)tok * FFD + c8), gt);
#pragma unroll
        for (int i = 0; i < 8; ++i) acc[i] = gelu_tanh(acc[i]) * gt[i];
        *(u32x4*)(Gt + (size_t)tok * FFD + c8) = pack8(acc);
    }
}
__device__ __forceinline__ void phase_final(KA a) {
    const float* ssq = (const float*)(a->ws + OFF_SSQ); const float* gf = a->in[3]; float* out = a->out; const bf16_t* X = (const bf16_t*)(a->ws + OFF_XG);
    const int G = gridDim.x, tid = tid_now(), lane = tid & 63, wave = tid >> 6;
    f32x4 g[4];
#pragma unroll
    for (int i = 0; i < 4; ++i) g[i] = *(const f32x4*)(gf + (i >> 1) * 512 + lane * 8 + (i & 1) * 4);
    for (int row0 = blockIdx.x * 8 + wave; row0 < T_TOK; row0 += G * 8 * 4) {
        u32x4 xw[4][2]; f32x4 sq[4];
#pragma unroll
        for (int rr = 0; rr < 4; ++rr) { const int row = (row0 + rr * G * 8 < T_TOK) ? row0 + rr * G * 8 : T_TOK - 1;
            xw[rr][0] = *(const u32x4*)(X + (size_t)row * 1024 + lane * 8); xw[rr][1] = *(const u32x4*)(X + (size_t)row * 1024 + 512 + lane * 8); sq[rr] = *(const f32x4*)(ssq + (size_t)row * 4); }
#pragma unroll
        for (int rr = 0; rr < 4; ++rr) { const int row = row0 + rr * G * 8; if (row >= T_TOK) continue;
            const float rs = rsqrtf(((sq[rr][0] + sq[rr][1]) + (sq[rr][2] + sq[rr][3])) * (1.0f / 1024.0f) + 1e-6f);
#pragma unroll
            for (int hh = 0; hh < 2; ++hh) { float xv[8]; unpack8(xw[rr][hh], xv); float* op = out + (size_t)row * 1024 + hh * 512 + lane * 8;
                *(f32x4*)op = (f32x4){xv[0], xv[1], xv[2], xv[3]} * rs * g[2 * hh]; *(f32x4*)(op + 4) = (f32x4){xv[4], xv[5], xv[6], xv[7]} * rs * g[2 * hh + 1]; } }
    }
}
__device__ __forceinline__ void act_fixup(KA a, int l, int pm) {
    const float* EU = (const float*)(a->ws + OFF_EU); const float* EG = (const float*)(a->ws + OFF_EG); bf16_t* ACT = (bf16_t*)(a->ws + OFF_G);
    const float* cw = a->in[22] + (size_t)l * 3 * FFD; const float* cb = a->in[23] + (size_t)l * FFD;
    const bool first = (pm & 31) == 0;
    const int tid0 = tid_now();
#pragma unroll
    for (int k = 0; k < 11; ++k) { const int e = tid0 + 512 * k; const int rr = e >= FFD ? 1 : 0, col = e - rr * FFD;
        const float u0 = EU[((size_t)(pm * 4 + rr)) * FFD + col];
        const float pl = first ? 0.f : EU[((size_t)((pm - 1) * 4 + 3)) * FFD + col];
        float u1, u2;
        if (rr == 0) { u1 = pl; u2 = first ? 0.f : EU[((size_t)((pm - 1) * 4 + 2)) * FFD + col]; }
        else { u1 = EU[((size_t)(pm * 4)) * FFD + col]; u2 = pl; }
        const float g = EG[((size_t)(pm * 2 + rr)) * FFD + col];
        const float v = gelu_tanh(cb[col] + cw[2 * FFD + col] * u0 + cw[FFD + col] * u1 + cw[col] * u2) * g;
        ACT[((size_t)(pm * 256 + rr)) * FFD + col] = f2bf(v); }
}
#ifndef STAG_N
#define STAG_N 3
#endif
#define STAGGER() do { if ((bx >> 3) & 1) { for (int s_ = 0; s_ < STAG_N; ++s_) __builtin_amdgcn_s_sleep(127); } } while (0)
#ifndef REP_G1_SKIP
#define REP_G1_SKIP 0
#endif
#ifndef REP_BAR
#define REP_BAR 1
#endif
#ifndef REP_LRU1
#define REP_LRU1 1
#endif
#ifndef REP_SCONV
#define REP_SCONV 1
#endif
#ifndef REP_LRU2
#define REP_LRU2 1
#endif
#ifndef REP_HG1
#define REP_HG1 1
#endif
#ifndef REP_POOL
#define REP_POOL 1
#endif
#ifndef REP_HG2
#define REP_HG2 1
#endif
#ifndef G1_ALIGN
#define G1_ALIGN true
#endif
#ifndef REP_SYNC
#define REP_SYNC 1
#endif
#ifndef REP_G1
#define REP_G1 1
#endif
#ifndef REP_EVEN
#define REP_EVEN 1
#endif
#ifndef REP_ODD
#define REP_ODD 1
#endif
#ifndef REP_PRO
#define REP_PRO 1
#endif
#ifndef REP_G3
#define REP_G3 1
#endif
__global__ void __launch_bounds__(512, 2) mega_fwd(Args a_byval) {
    extern __shared__ __attribute__((aligned(16))) unsigned char lds_raw[];
    LAS unsigned char* lds = (LAS unsigned char*)lds_raw;
    cg::grid_group grid = cg::this_grid();
    KA a0 = (KA)__builtin_amdgcn_kernarg_segment_ptr();
    volatile LAS unsigned* xst = (volatile LAS unsigned*)(lds + LDS_BYTES - 256);
    if (threadIdx.x < 4) xst[threadIdx.x] = 0u;
    __syncthreads();
    if (blockIdx.x == 0) { unsigned* bw = (unsigned*)(a0->ws + OFF_BAR); for (int i = threadIdx.x; i < XCD_BAR_WORDS; i += 512) bw[i] = 0u; }
    XcdBarrier xbar; xbar.bar = (unsigned*)(a0->ws + OFF_BAR); xbar.x = 0u; xbar.st = xst;
    const int G = gridDim.x, bx = blockIdx.x;
    const int ph_lo = a0->ph_lo, ph_hi = a0->ph_hi;
    for (int ph = ph_lo; ph < ph_hi; ++ph) {
        bool did = true;
        KA a = a0; asm volatile("" : "+s"(a));
        float* ssq = (float*)(a->ws + OFF_SSQ);
        bf16_t* XG = (bf16_t*)(a->ws + OFF_XG); bf16_t* Ub = (bf16_t*)(a->ws + OFF_U); bf16_t* Gb = (bf16_t*)(a->ws + OFF_G);
        if (ph == 0) { for (int rep = 0; rep < REP_PRO; ++rep) phase_prologue(a, lds); }
        else if (ph == 33) phase_final(a);
        else {
            const int l = (ph - 1) >> 3, s = (ph - 1) & 7, odd = l & 1, hl = l >> 1;
            const bf16_t* Wl = (const bf16_t*)(a->ws + OFF_W) + (size_t)l * W_LAYER;
            if (s == 0) {
                pg8::Gemm g{XG, Wl + W_IN, T_TOK, ZW, DM}; pg8::StaticOrder S; S.init(T_TOK, ZW, G, bx);
                pg8::EpiScale E{Ub, ZW, ssq, 0};
                for (int rep = 0; rep < REP_G1; ++rep) { E.skip = (rep > 0) ? REP_G1_SKIP : 0; pg8::gemm_phase<pg8::EpiScale, pg8::StaticOrder, G1_ALIGN, true>(lds, g, S, E); }
            } else if (s == 1) { for (int rep = 0; rep < (odd ? REP_ODD : REP_EVEN); ++rep) {
                if (!odd) { for (int r1 = 0; r1 < REP_LRU1; ++r1) { int ph_ = -1; u32x4 pf[3]; lru_load_xh(a, bx & 2047, tid_now(), pf); for (int u = bx; u < 2048; u += G) { lru_unit(a, lds, hl, u, 1, (u & 7) != ph_, pf, (u + G < 2048) ? u + G : -1); ph_ = u & 7; } }
                            for (int r2 = 0; r2 < REP_SCONV; ++r2) for (int u = bx; u < 1024; u += G) sconv_unit(a, hl, u); }
                else      { for (int r1 = 0; r1 < REP_HG1; ++r1) { u32x4 nx[6]; hgrn_load_first(a, bx & 511, tid_now(), 1, nx); for (int u = bx; u < 512; u += G) hgrn_unit(a, lds, hl, u, 1, nx, (u + G < 512) ? u + G : -1); }
                            for (int r2 = 0; r2 < REP_POOL; ++r2) { int pg_ = -1; u32x4 pq[5]; pool_load_uh(a, bx & 1023, tid_now(), pq); for (int u = bx; u < 1024; u += G) { pool_unit(a, lds, hl, u, (u & 3) != pg_, pq, (u + G < 1024) ? u + G : -1); pg_ = u & 3; } } } }
            } else if (s == 2) {
                if (odd) hgrn_scan(a); else did = false;
            } else if (s == 3) { for (int rep = 0; rep < (odd ? REP_ODD : REP_EVEN); ++rep) {
                if (!odd) { for (int r1 = 0; r1 < REP_LRU2; ++r1) { int ph_ = -1; u32x4 pf[3]; lru_load_xh(a, bx & 2047, tid_now(), pf); for (int u = bx; u < 2048; u += G) { lru_unit(a, lds, hl, u, 2, (u & 7) != ph_, pf, (u + G < 2048) ? u + G : -1); ph_ = u & 7; } } }
                else      { for (int r1 = 0; r1 < REP_HG2; ++r1) { u32x4 nx[6]; hgrn_load_first(a, bx & 511, tid_now(), 2, nx); for (int u = bx; u < 512; u += G) hgrn_unit(a, lds, hl, u, 2, nx, (u + G < 512) ? u + G : -1); } } }
            } else if (s == 4 || s == 7) {
                const bool dn = (s == 7);
                pg8::Gemm g{dn ? Gb : Gb  , Wl + (dn ? W_DN : W_OUT), T_TOK, DM, dn ? FFD : DM}; pg8::StaticOrder S; S.init(T_TOK, DM, G, bx);
                if (dn) { pg8::Unit fu; for (int i = 0; S.next(i, fu); ++i) act_fixup(a, l, fu.pm);
                          asm volatile("s_waitcnt vmcnt(0)" ::: "memory"); __syncthreads(); }
                pg8::EpiRes E{XG, ssq, (LAS float*)(lds + 131072)};
                pg8::gemm_phase<pg8::EpiRes, pg8::StaticOrder, true, true>(lds, g, S, E);
            } else if (s == 5) {
                pg8::Gemm g{XG, Wl + W_UG, T_TOK, 2 * FFD, DM}; pg8::StaticOrder S; S.init(T_TOK, 2 * FFD, G, bx);
                pg8::EpiAct E{Gb, ssq, a->in[22] + (size_t)l * 3 * FFD, a->in[23] + (size_t)l * FFD, (float*)(a->ws + OFF_EU), (float*)(a->ws + OFF_EG), (LAS float*)(lds + 131072)};
                for (int rep = 0; rep < REP_G3; ++rep) pg8::gemm_phase<pg8::EpiAct, pg8::StaticOrder, true, true>(lds, g, S, E);
            } else { did = false; }
        }
        if (did && ph + 1 < ph_hi) { if (ph == 0) { grid.sync(); xbar = xcd_barrier_post((unsigned*)(a0->ws + OFF_BAR), xst); } else { for (int rb = 0; rb < REP_BAR; ++rb) xcd_barrier(xbar); } }
    }
}

#ifndef MK_MULTI
#define MK_MULTI 0
#endif
extern "C" void kernel_launch(void* const* d_in, const int* in_sizes, int n_in, void* d_out, int out_size, void* d_ws, size_t ws_size, hipStream_t stream) {
    static int grid = 0;
    if (grid == 0) {
        if (n_in != 25 || ws_size < WS_END) { fprintf(stderr, "kernel_launch: unexpected n_in %d or ws_size %zu (< %zu)\n", n_in, ws_size, (size_t)WS_END); grid = -1; return; }
        int dev = 0, cus = 0, per_cu = 0;
        if (hipGetDevice(&dev) != hipSuccess || hipDeviceGetAttribute(&cus, hipDeviceAttributeMultiprocessorCount, dev) != hipSuccess) { grid = -1; return; }
        if (hipFuncSetAttribute((const void*)mega_fwd, hipFuncAttributeMaxDynamicSharedMemorySize, LDS_BYTES) != hipSuccess) { fprintf(stderr, "kernel_launch: hipFuncSetAttribute failed\n"); grid = -1; return; }
        if (hipOccupancyMaxActiveBlocksPerMultiprocessor(&per_cu, (const void*)mega_fwd, 512, LDS_BYTES) != hipSuccess || per_cu < 1) fprintf(stderr, "kernel_launch: occupancy query says %d\n", per_cu);
        (void)hipGetLastError();
        grid = cus;
    }
    if (grid < 0) return;
    Args a{};
    for (int i = 0; i < 25; ++i) a.in[i] = (const float*)d_in[i];
    a.out = (float*)d_out; a.ws = (unsigned char*)d_ws;
#if MK_MULTI
    for (int ph = 0; ph < 34; ++ph) { a.ph_lo = ph; a.ph_hi = ph + 1; void* args[] = {&a};
        if (ph >= 1 && ph < 33 && ((ph - 1) & 7) == 2 && (((ph - 1) >> 3) & 1) == 0) continue;
        hipError_t e = hipLaunchCooperativeKernel((const void*)mega_fwd, dim3(grid), dim3(512), args, LDS_BYTES, stream);
        if (e != hipSuccess) { fprintf(stderr, "launch %d failed: %s\n", ph, hipGetErrorString(e)); break; } }
#else
    a.ph_lo = 0; a.ph_hi = 34; void* args[] = {&a};
    hipError_t e = hipLaunchCooperativeKernel((const void*)mega_fwd, dim3(grid), dim3(512), args, LDS_BYTES, stream);
    if (e != hipSuccess) fprintf(stderr, "cooperative launch failed: %s (grid %d)\n", hipGetErrorString(e), grid);
#endif
}
```
